# Optimizing an MI355X kernel written in HIP

```python
import jax, jax.numpy as jnp
from jax import lax
import numpy as np

D_MODEL = 1024
BATCH = 1
SEQ = 16384
DEPTH = 4
DEC_BATCH = 32
DEC_SEQ = 16
PAST_LEN = 1024

CHUNK = 64
D_PLE = 256
A_HEADS = 8
A_KV_HEADS = 2
A_HEAD_DIM = 64
A_GROUP = A_HEADS // A_KV_HEADS
A_WIDTH = A_HEADS * A_HEAD_DIM
A_KV_WIDTH = A_KV_HEADS * A_HEAD_DIM
WINDOW = 128
WINDOW_CHUNKS = WINDOW // CHUNK
ROT_DIM = A_HEAD_DIM // 4
ROPE_THETA = 500000.0
B_HEADS = 4
B_KEY_DIM = 64
B_VAL_DIM = 128
B_QK_WIDTH = B_HEADS * B_KEY_DIM
B_WIDTH = B_HEADS * B_VAL_DIM
GATE_RANK = 16
GATE_TAU = 16.0
GLA_BLOCK = 16
D_MIX = A_WIDTH + B_WIDTH
IN_SPLITS = (A_WIDTH, A_KV_WIDTH, A_KV_WIDTH, A_WIDTH, B_QK_WIDTH, B_QK_WIDTH, B_WIDTH, B_WIDTH, GATE_RANK)
IN_COLS = sum(IN_SPLITS)
NEG_INF = -1e30

kernel_name = "hymba_swa_sink_gla_streaming_step"


def _split_points():
    pts, acc = [], 0
    for n in IN_SPLITS[:-1]:
        acc += n
        pts.append(acc)
    return pts


def rms_norm(x, g, eps=1e-6):
    xf = x.astype(jnp.float32)
    y = xf * lax.rsqrt(jnp.mean(xf * xf, axis=-1, keepdims=True) + eps)
    return (y * g.astype(jnp.float32)).astype(x.dtype)


def partial_rope(x, pos):
    half = ROT_DIM // 2
    inv = jnp.power(jnp.float32(ROPE_THETA), -jnp.arange(half, dtype=jnp.float32) * (2.0 / ROT_DIM))
    ang = pos.astype(jnp.float32)[:, None] * inv[None, :]
    cos = jnp.cos(ang)[None, :, None, :]
    sin = jnp.sin(ang)[None, :, None, :]
    xr = x[..., :ROT_DIM].astype(jnp.float32)
    x1, x2 = xr[..., :half], xr[..., half:]
    rot = jnp.concatenate([x1 * cos - x2 * sin, x2 * cos + x1 * sin], axis=-1).astype(x.dtype)
    return jnp.concatenate([rot, x[..., ROT_DIM:]], axis=-1)


def sink_softmax_av(s, valid, sink, v, eq):
    if valid is not None:
        s = jnp.where(valid, s, NEG_INF)
    sk = sink.astype(jnp.float32)[:, :, None, None]
    m = jnp.maximum(jnp.max(s, axis=-1, keepdims=True), sk)
    pr = jnp.exp(s - m)
    den = jnp.sum(pr, axis=-1, keepdims=True) + jnp.exp(sk - m)
    return jnp.einsum(eq, pr / den, v.astype(jnp.float32))


def swa_prompt(q, k, v, sink):
    bn, L = q.shape[0], q.shape[1]
    nc = L // CHUNK
    band = (WINDOW_CHUNKS + 1) * CHUNK
    qc = q.reshape(bn, nc, CHUNK, A_KV_HEADS, A_GROUP, A_HEAD_DIM).astype(jnp.float32)
    pad = ((0, 0), (WINDOW_CHUNKS * CHUNK, 0), (0, 0), (0, 0))
    kp = jnp.pad(k, pad).reshape(bn, nc + WINDOW_CHUNKS, CHUNK, A_KV_HEADS, A_HEAD_DIM)
    vp = jnp.pad(v, pad).reshape(bn, nc + WINDOW_CHUNKS, CHUNK, A_KV_HEADS, A_HEAD_DIM)
    kb = jnp.concatenate([kp[:, j:j + nc] for j in range(WINDOW_CHUNKS + 1)], axis=2)
    vb = jnp.concatenate([vp[:, j:j + nc] for j in range(WINDOW_CHUNKS + 1)], axis=2)
    key_chunk = jnp.arange(nc)[:, None] - WINDOW_CHUNKS + (jnp.arange(band) // CHUNK)[None, :]
    valid = (key_chunk >= 0).reshape(1, nc, 1, 1, 1, band)
    s = jnp.einsum('bnqkgd,bnskd->bnkgqs', qc, kb.astype(jnp.float32)) * (A_HEAD_DIM ** -0.5)
    o = sink_softmax_av(s, valid, sink.reshape(A_KV_HEADS, A_GROUP), vb, 'bnkgqs,bnskd->bnqkgd')
    return o.reshape(bn, L, A_HEADS, A_HEAD_DIM).astype(q.dtype)


def swa_sample(q, k, v, ck, cv, sink):
    bn, T = q.shape[0], q.shape[1]
    kk = jnp.concatenate([ck.astype(k.dtype), k], axis=1).astype(jnp.float32)
    vv = jnp.concatenate([cv.astype(v.dtype), v], axis=1)
    qg = q.reshape(bn, T, A_KV_HEADS, A_GROUP, A_HEAD_DIM).astype(jnp.float32)
    s = jnp.einsum('bqkgd,bskd->bkgqs', qg, kk) * (A_HEAD_DIM ** -0.5)
    o = sink_softmax_av(s, None, sink.reshape(A_KV_HEADS, A_GROUP), vv, 'bkgqs,bskd->bqkgd')
    return o.reshape(bn, T, A_HEADS, A_HEAD_DIM).astype(q.dtype)


def gla_recurrent(q, k, v, logg, s0):
    bn, L, H, DK = q.shape
    DV = v.shape[-1]
    Lp = -(-L // GLA_BLOCK) * GLA_BLOCK
    padw = ((0, 0), (0, Lp - L), (0, 0), (0, 0))
    nb = Lp // GLA_BLOCK
    f = lambda a: jnp.pad(a.astype(jnp.float32), padw).reshape(bn, nb, GLA_BLOCK, H, a.shape[-1])
    qf, kf, vf, gf = f(q), f(k), f(v), f(logg)
    b = jnp.cumsum(gf, axis=2)
    b_last = b[:, :, -1:]
    qt = qf * jnp.exp(b)
    kt = kf * jnp.exp(-b)
    ke = kf * jnp.exp(b_last - b)
    causal = jnp.tril(jnp.ones((GLA_BLOCK, GLA_BLOCK), dtype=bool))
    att = jnp.einsum('bnthk,bnshk->bnhts', qt, kt)
    o_intra = jnp.einsum('bnhts,bnshv->bnthv', jnp.where(causal, att, 0.0), vf)

    def step(S, xs):
        qt_n, ke_n, v_n, dec_n = xs
        o = jnp.einsum('bthk,bhkv->bthv', qt_n, S)
        S = dec_n[..., None] * S + jnp.einsum('bthk,bthv->bhkv', ke_n, v_n)
        return S, o

    xs = (jnp.moveaxis(qt, 1, 0), jnp.moveaxis(ke, 1, 0), jnp.moveaxis(vf, 1, 0),
          jnp.moveaxis(jnp.exp(b_last[:, :, 0]), 1, 0))
    s_fin, o_inter = lax.scan(step, s0.astype(jnp.float32), xs)
    o = (o_intra + jnp.moveaxis(o_inter, 0, 1)).reshape(bn, Lp, H, DV)[:, :L]
    return o.astype(v.dtype), s_fin.astype(s0.dtype)


def trunk_layer(h, p_l, pos, ck, cv, s0, norm_g, w_in, q_norm_g, k_norm_g, sinks, w_gate_up, b_gate,
                gla_norm_g, w_out, pe_norm_g, w_pe, w_pg):
    bn, L = h.shape[0], h.shape[1]
    xn = rms_norm(h, norm_g)
    u = xn @ w_in
    qa, ka, va, ga, qb, kb, vb, gb, ab = jnp.split(u, _split_points(), axis=-1)
    qa = partial_rope(rms_norm(qa.reshape(bn, L, A_HEADS, A_HEAD_DIM), q_norm_g), pos)
    ka = partial_rope(rms_norm(ka.reshape(bn, L, A_KV_HEADS, A_HEAD_DIM), k_norm_g), pos)
    va = va.reshape(bn, L, A_KV_HEADS, A_HEAD_DIM)
    if ck is None:
        oa = swa_prompt(qa, ka, va, sinks)
        new_k, new_v = ka[:, L - WINDOW:], va[:, L - WINDOW:]
    else:
        oa = swa_sample(qa, ka, va, ck, cv, sinks)
        new_k, new_v = ka, va
    qb = qb.reshape(bn, L, B_HEADS, B_KEY_DIM) * (B_KEY_DIM ** -0.5)
    kb = kb.reshape(bn, L, B_HEADS, B_KEY_DIM)
    vb = vb.reshape(bn, L, B_HEADS, B_VAL_DIM)
    logg = jax.nn.log_sigmoid((ab @ w_gate_up + b_gate).astype(jnp.float32)) / GATE_TAU
    logg = logg.reshape(bn, L, B_HEADS, B_KEY_DIM)
    if s0 is None:
        s0 = jnp.zeros((bn, B_HEADS, B_KEY_DIM, B_VAL_DIM), h.dtype)
    ob, s_new = gla_recurrent(qb, kb, vb, logg, s0)
    ob = rms_norm(ob, gla_norm_g)
    mix = jnp.concatenate([oa.reshape(bn, L, A_WIDTH) * jax.nn.silu(ga),
                           ob.reshape(bn, L, B_WIDTH) * jax.nn.silu(gb)], axis=-1)
    h = h + mix @ w_out
    gate = jax.nn.sigmoid(rms_norm(h, pe_norm_g) @ w_pg)
    h = h + gate * (p_l @ w_pe)
    return h, new_k, new_v, s_new


def setup_inputs(seed: int = 0) -> dict:
    key = jax.random.key(seed)
    ks = jax.random.split(key, 20)
    f32 = jnp.float32
    nrm = lambda k, shape, s: jax.random.normal(k, shape, f32) * s
    swa_rows = min(WINDOW, PAST_LEN)
    return {
        "x_prompt": nrm(ks[0], (BATCH, SEQ, D_MODEL), 1.0),
        "x_sample": nrm(ks[1], (DEC_BATCH, DEC_SEQ, D_MODEL), 1.0),
        "cache_k": nrm(ks[2], (DEPTH, DEC_BATCH, swa_rows, A_KV_HEADS, A_HEAD_DIM), 1.0),
        "cache_v": nrm(ks[3], (DEPTH, DEC_BATCH, swa_rows, A_KV_HEADS, A_HEAD_DIM), 1.0),
        "state_gla": nrm(ks[4], (DEPTH, DEC_BATCH, B_HEADS, B_KEY_DIM, B_VAL_DIM), 0.5),
        "p_prompt": nrm(ks[5], (DEPTH, BATCH, SEQ, D_PLE), 1.0),
        "p_sample": nrm(ks[6], (DEPTH, DEC_BATCH, DEC_SEQ, D_PLE), 1.0),
        "norm_g": 1.0 + nrm(ks[7], (DEPTH, D_MODEL), 0.02),
        "w_in": nrm(ks[8], (DEPTH, D_MODEL, IN_COLS), D_MODEL ** -0.5),
        "q_norm_g": 1.0 + nrm(ks[9], (DEPTH, A_HEAD_DIM), 0.02),
        "k_norm_g": 1.0 + nrm(ks[10], (DEPTH, A_HEAD_DIM), 0.02),
        "sinks": nrm(ks[11], (DEPTH, A_HEADS), 0.5),
        "w_gate_up": nrm(ks[12], (DEPTH, GATE_RANK, B_QK_WIDTH), GATE_RANK ** -0.5),
        "b_gate": nrm(ks[13], (DEPTH, B_QK_WIDTH), 0.1),
        "gla_norm_g": 1.0 + nrm(ks[14], (DEPTH, B_VAL_DIM), 0.02),
        "w_out": nrm(ks[15], (DEPTH, D_MIX, D_MODEL), D_MIX ** -0.5),
        "pe_norm_g": 1.0 + nrm(ks[16], (DEPTH, D_MODEL), 0.02),
        "w_pe": nrm(ks[17], (DEPTH, D_PLE, D_MODEL), D_PLE ** -0.5),
        "w_pg": nrm(ks[18], (DEPTH, D_MODEL, D_MODEL), D_MODEL ** -0.5),
    }


def reference(x_prompt, x_sample, cache_k, cache_v, state_gla, p_prompt, p_sample, norm_g, w_in,
              q_norm_g, k_norm_g, sinks, w_gate_up, b_gate, gla_norm_g, w_out, pe_norm_g, w_pe, w_pg):
    pos_prompt = jnp.arange(x_prompt.shape[1], dtype=jnp.int32)
    pos_sample = PAST_LEN + jnp.arange(x_sample.shape[1], dtype=jnp.int32)
    hp, hs = x_prompt, x_sample
    kp_l, vp_l, sp_l, ks_l, vs_l, ss_l = [], [], [], [], [], []
    for i in range(DEPTH):
        lw = (norm_g[i], w_in[i], q_norm_g[i], k_norm_g[i], sinks[i], w_gate_up[i], b_gate[i],
              gla_norm_g[i], w_out[i], pe_norm_g[i], w_pe[i], w_pg[i])
        hp, kn, vn, sn = trunk_layer(hp, p_prompt[i], pos_prompt, None, None, None, *lw)
        kp_l.append(kn); vp_l.append(vn); sp_l.append(sn)
        hs, kn, vn, sn = trunk_layer(hs, p_sample[i], pos_sample, cache_k[i], cache_v[i], state_gla[i], *lw)
        ks_l.append(kn); vs_l.append(vn); ss_l.append(sn)
    return (hp, hs, jnp.stack(kp_l), jnp.stack(vp_l), jnp.stack(sp_l),
            jnp.stack(ks_l), jnp.stack(vs_l), jnp.stack(ss_l))
```

```cpp
#include <hip/hip_runtime.h>
#include <hip/hip_cooperative_groups.h>
#include <cstdio>
namespace cg = cooperative_groups;

#define DI __device__ __forceinline__
typedef __attribute__((ext_vector_type(8))) short bf16x8;
typedef __attribute__((ext_vector_type(16))) float f32x16;
typedef __attribute__((ext_vector_type(2))) __bf16 bf2_t;
typedef unsigned short u16;

constexpr int TP = 16384, TS = 512, TT = TP + TS;
constexpr int DM = 1024, DEPTH = 4, DPLE = 256;
constexpr int NIN = 2832, NINP = 2944;
constexpr int NTHR = 256;
constexpr int MT = TT / 128;
constexpr int NCH = TP / 64;
constexpr int TPS = TP + 192;
constexpr int XCD_BAR_WORDS_C = 4032;

constexpr size_t O_Y = 0;
constexpr size_t O_KP = (size_t)TT * DM;
constexpr size_t O_VP = O_KP + 4 * 16384;
constexpr size_t O_SP = O_VP + 4 * 16384;
constexpr size_t O_KS = O_SP + 4 * 32768;
constexpr size_t O_VS = O_KS + 4 * 65536;
constexpr size_t O_SS = O_VS + 4 * 65536;

constexpr size_t W_WIN = 0;
constexpr size_t W_WOUT = W_WIN + (size_t)DEPTH * NINP * DM * 2;
constexpr size_t W_WPG = W_WOUT + (size_t)DEPTH * DM * DM * 2;
constexpr size_t W_WPE = W_WPG + (size_t)DEPTH * DM * DM * 2;
constexpr size_t W_HB = W_WPE + (size_t)DEPTH * DM * DPLE * 2;
constexpr size_t W_Q = W_HB + (size_t)TT * DM * 2;
constexpr size_t W_K = W_Q + (size_t)TT * 512 * 2;
constexpr size_t W_VT = W_K + (size_t)TT * 128 * 2;
constexpr size_t W_GATE = W_VT + (size_t)128 * TPS * 2;
constexpr size_t W_QB = W_GATE + (size_t)TT * DM * 2;
constexpr size_t W_KB = W_QB + (size_t)TT * 256 * 2;
constexpr size_t W_KBT = W_KB + (size_t)TT * 256 * 2;
constexpr size_t W_VBS = W_KBT + (size_t)256 * TPS * 2;
constexpr size_t W_VBT = W_VBS + (size_t)TS * 512 * 2;
constexpr size_t W_AB = W_VBT + (size_t)512 * TPS * 2;
constexpr size_t W_MIX = W_AB + (size_t)TT * 16 * 4;
constexpr size_t W_S = W_MIX + (size_t)TT * DM * 2;
constexpr size_t W_DEC = W_S + (size_t)NCH * 32768 * 4;
constexpr size_t W_ROPE = W_DEC + (size_t)NCH * 256 * 4;
constexpr size_t W_SSA = W_ROPE + (size_t)TP * 16 * 4;
constexpr size_t W_SSD = W_SSA + (size_t)TT * 4;
constexpr size_t W_PB = W_SSD + (size_t)TT * 4;
constexpr size_t W_BAR = W_PB + (size_t)TP * DPLE * 2;
constexpr size_t W_END = W_BAR + XCD_BAR_WORDS_C * 4;

constexpr int LDS_HALF = 128 * 132 * 4 + 512;
constexpr int LDS_MAIN = 2 * LDS_HALF;
constexpr int LDS_BYTES = LDS_MAIN + 16;
constexpr int NBLK_THREADS = 512;

struct Params {
  const float *x_prompt, *x_sample, *cache_k, *cache_v, *state_gla, *p_prompt, *p_sample, *norm_g, *w_in, *q_norm_g, *k_norm_g,
      *sinks, *w_gate_up, *b_gate, *gla_norm_g, *w_out, *pe_norm_g, *w_pe, *w_pg;
  float* out;
  char* ws;
};

DI unsigned pk2(float a, float b) { bf2_t v; v[0] = (__bf16)a; v[1] = (__bf16)b; return __builtin_bit_cast(unsigned, v); }
DI float bflo(unsigned u) { return __uint_as_float(u << 16); }
DI float bfhi(unsigned u) { return __uint_as_float(u & 0xffff0000u); }
DI float bf2f(u16 u) { return __uint_as_float(((unsigned)u) << 16); }
DI uint4 pk8(const float* v) { return make_uint4(pk2(v[0], v[1]), pk2(v[2], v[3]), pk2(v[4], v[5]), pk2(v[6], v[7])); }
DI void unpk8(uint4 u, float* v) {
  v[0] = bflo(u.x); v[1] = bfhi(u.x); v[2] = bflo(u.y); v[3] = bfhi(u.y);
  v[4] = bflo(u.z); v[5] = bfhi(u.z); v[6] = bflo(u.w); v[7] = bfhi(u.w);
}
DI int otid() { int t = threadIdx.x & 255; asm volatile("" : "+v"(t)); return t; }
DI int hhalf() { return __builtin_amdgcn_readfirstlane((int)(threadIdx.x >> 8)); }
DI int vbid() { return (int)blockIdx.x * 2 + hhalf(); }
DI int obid() { int b = blockIdx.x; asm volatile("" : "+s"(b)); return b; }
DI int vgrid() { return (int)gridDim.x * 2; }
DI size_t tidx(int NR, int col, int token) { return ((size_t)(token >> 6) * NR + col) * 64 + (token & 63); }
DI int crow(int reg, int h) { return (reg & 3) + 8 * (reg >> 2) + 4 * h; }
#define MFMA(a, b, c) __builtin_amdgcn_mfma_f32_32x32x16_bf16((a), (b), (c), 0, 0, 0)
DI bf16x8 as_frag(uint4 u) { return __builtin_bit_cast(bf16x8, u); }
DI f32x16 zero16() { f32x16 z; for (int i = 0; i < 16; ++i) z[i] = 0.f; return z; }
DI float sigmoidf_(float x) { return __builtin_amdgcn_rcpf(1.f + __expf(-x)); }
DI float siluf_(float x) { return x * __builtin_amdgcn_rcpf(1.f + __expf(-x)); }
DI float logsigmoidf_(float z) { return fminf(z, 0.f) - __logf(1.f + __expf(-fabsf(z))); }


#define XB_TMO      128
#define XB_XCNT(j)  (256  + 64 * (j))
#define XB_XSUB(j)  (1280 + 64 * (j))
#define XB_XGEN(j)  (2304 + 64 * (j))
#define XB_TOP      3328
#define XB_TOPGEN   3392
#define XB_RANK(j)  (3456 + 64 * (j))
#define XCD_BAR_WORDS 4032
#define XB_SPIN_CAP (1u << 22)
#define LAS __attribute__((address_space(3)))
DI unsigned xb_ld(unsigned* p) { return __hip_atomic_load(p, __ATOMIC_RELAXED, __HIP_MEMORY_SCOPE_AGENT); }
DI unsigned xb_add(unsigned* p, unsigned v) { return __hip_atomic_fetch_add(p, v, __ATOMIC_RELAXED, __HIP_MEMORY_SCOPE_AGENT); }
DI unsigned xb_xcc_id() { return (unsigned)__builtin_amdgcn_s_getreg((3 << 11) | 20) & 0xFu; }
#define XB_SPIN(cond, bar) do { unsigned _sp = 0; while (cond) { __builtin_amdgcn_s_sleep(1); \
    if ((++_sp & 255u) == 0u) { if (xb_ld(&(bar)[XB_TMO])) break; if (_sp > XB_SPIN_CAP) { atomicAdd(&(bar)[XB_TMO], 1u); break; } } } } while (0)
struct XcdBarrier { unsigned* bar; unsigned x; volatile LAS unsigned* st; };
DI XcdBarrier xcd_barrier_post(unsigned* bar, volatile LAS unsigned* st) {
  XcdBarrier b; b.bar = bar; b.x = xb_xcc_id(); b.st = st;
  if (threadIdx.x == 0) (void)xb_add(&bar[XB_XCNT(b.x)], 1u);
  return b;
}
DI void xcd_barrier_complete(unsigned* bar, unsigned x, unsigned& nloc, unsigned& nx) {
  const unsigned G = gridDim.x * gridDim.y * gridDim.z;
  unsigned sum, cnt, mine, sp = 0u;
  for (;;) {
    sum = 0u; cnt = 0u; mine = 0u;
#pragma unroll
    for (unsigned j = 0; j < 16; ++j) { const unsigned c = xb_ld(&bar[XB_XCNT(j)]); sum += c; cnt += (c > 0u) ? 1u : 0u; mine = (j == x) ? c : mine; }
    if (sum == G) break;
    __builtin_amdgcn_s_sleep(1);
    if ((++sp & 255u) == 0u) { if (xb_ld(&bar[XB_TMO])) break; if (sp > XB_SPIN_CAP) { atomicAdd(&bar[XB_TMO], 1u); break; } }
  }
  nloc = mine > 0u ? mine : 1u; nx = cnt > 0u ? cnt : 1u;
}
DI void xcd_barrier(const XcdBarrier& b) {
  asm volatile("s_waitcnt vmcnt(0)" ::: "memory");
  __syncthreads();
  if (threadIdx.x == 0) {
    unsigned* bar = b.bar;
    __builtin_amdgcn_s_waitcnt(0);
    unsigned nloc = b.st[0], nx = b.st[1];
    if (nloc == 0u) { xcd_barrier_complete(bar, b.x, nloc, nx); b.st[0] = nloc; b.st[1] = nx; }
    const unsigned old = xb_add(&bar[XB_XSUB(b.x)], 1u);
    const unsigned gen = old / nloc;
    if (old + 1u == (gen + 1u) * nloc) {
      __builtin_amdgcn_fence(__ATOMIC_RELEASE, "agent");
      asm volatile("s_waitcnt vmcnt(0)" ::: "memory");
      const unsigned og = xb_add(&bar[XB_TOP], 1u);
      const unsigned tg = og / nx;
      if (og + 1u == (tg + 1u) * nx) xb_add(&bar[XB_TOPGEN], 1u);
      else XB_SPIN(xb_ld(&bar[XB_TOPGEN]) == tg, bar);
      __builtin_amdgcn_fence(__ATOMIC_ACQUIRE, "agent");
      xb_add(&bar[XB_XGEN(b.x)], 1u);
      asm volatile("s_waitcnt vmcnt(0)" ::: "memory");
    } else {
      XB_SPIN(xb_ld(&bar[XB_XGEN(b.x)]) == gen, bar);
      __builtin_amdgcn_fence(__ATOMIC_ACQUIRE, "agent");
      asm volatile("s_waitcnt vmcnt(0)" ::: "memory");
    }
  }
  __syncthreads();
}

struct GStage { uint4 a0, a1, a2, a3, b0, b1, b2, b3; };
template <bool AF32>
DI uint4 gl_a(const void* __restrict__ Ab, size_t off) {
  if (AF32) {
    const float* ap = (const float*)Ab + off;
    const float4 f0 = *(const float4*)ap, f1 = *(const float4*)(ap + 4);
    return make_uint4(pk2(f0.x, f0.y), pk2(f0.z, f0.w), pk2(f1.x, f1.y), pk2(f1.z, f1.w));
  }
  return *(const uint4*)((const u16*)Ab + off);
}
template <bool AF32>
DI void g_load(GStage& s, const void* __restrict__ Ab, int lda, const u16* __restrict__ Bb, int ldb, int kt, int sr, int sc) {
  const size_t ao = (size_t)sr * lda + kt * 64 + sc * 8, bo = (size_t)sr * ldb + kt * 64 + sc * 8;
  s.a0 = gl_a<AF32>(Ab, ao); s.a1 = gl_a<AF32>(Ab, ao + (size_t)32 * lda); s.a2 = gl_a<AF32>(Ab, ao + (size_t)64 * lda); s.a3 = gl_a<AF32>(Ab, ao + (size_t)96 * lda);
  s.b0 = *(const uint4*)(Bb + bo); s.b1 = *(const uint4*)(Bb + bo + (size_t)32 * ldb); s.b2 = *(const uint4*)(Bb + bo + (size_t)64 * ldb); s.b3 = *(const uint4*)(Bb + bo + (size_t)96 * ldb);
}
DI float sq8(uint4 u) { float v[8]; unpk8(u, v); float s = 0.f;
#pragma unroll
  for (int j = 0; j < 8; ++j) s += v[j] * v[j];
  return s; }
DI void l_store(const GStage& s, char* base, int sr, int sc) {
  char* a = base; char* b = base + 16384;
  const int sw = ((sc ^ ((sr >> 1) & 7)) << 4);
  const int o0 = sr * 128 + sw;
  *(uint4*)(a + o0) = s.a0; *(uint4*)(a + o0 + 4096) = s.a1; *(uint4*)(a + o0 + 8192) = s.a2; *(uint4*)(a + o0 + 12288) = s.a3;
  *(uint4*)(b + o0) = s.b0; *(uint4*)(b + o0 + 4096) = s.b1; *(uint4*)(b + o0 + 8192) = s.b2; *(uint4*)(b + o0 + 12288) = s.b3;
}
DI float sq8f(bf16x8 f) { const uint4 u = __builtin_bit_cast(uint4, f); return sq8(u); }
template <bool SUMSQ>
DI void mma_step(const char* a, f32x16 (&acc)[2][2], int wm, int wn, int r, int hh, float (&ss)[4]) {
  const char* b = a + 16384;
#pragma unroll
  for (int ks = 0; ks < 4; ++ks) {
    bf16x8 af[2], bfr[2];
#pragma unroll
    for (int i = 0; i < 2; ++i) {
      const int arow = wm * 64 + i * 32 + r;
      af[i] = *(const bf16x8*)(a + arow * 128 + (((2 * ks + hh) ^ ((arow >> 1) & 7)) << 4));
      const int brow = wn * 64 + i * 32 + r;
      bfr[i] = *(const bf16x8*)(b + brow * 128 + (((2 * ks + hh) ^ ((brow >> 1) & 7)) << 4));
    }
#pragma unroll
    for (int mi = 0; mi < 2; ++mi)
#pragma unroll
      for (int ni = 0; ni < 2; ++ni) acc[mi][ni] = MFMA(af[mi], bfr[ni], acc[mi][ni]);
    if (SUMSQ) { ss[0] += sq8f(af[0]); ss[1] += sq8f(af[1]); }
  }
}
template <bool AF32, bool SUMSQ>
DI void gemm_main(const void* __restrict__ Ab, int lda, const u16* __restrict__ Bb, int ldb, int K, f32x16 (&acc)[2][2], char* lds, float (&ss)[4]) {
  const int tid = otid(), lane = tid & 63, w = tid >> 6;
  const int wm = w >> 1, wn = w & 1, r = lane & 31, hh = lane >> 5;
  const int sc = tid & 7, sr = tid >> 3;
  GStage s0, s1;
  const int nk = K >> 6;
  g_load<AF32>(s0, Ab, lda, Bb, ldb, 0, sr, sc);
  g_load<AF32>(s1, Ab, lda, Bb, ldb, 1, sr, sc);
  l_store(s0, lds, sr, sc);
  __syncthreads();
  for (int kt = 0; kt < nk; kt += 2) {
    if (kt + 2 < nk) g_load<AF32>(s0, Ab, lda, Bb, ldb, kt + 2, sr, sc);
    __builtin_amdgcn_sched_barrier(0);
    mma_step<SUMSQ>(lds, acc, wm, wn, r, hh, ss);
    __builtin_amdgcn_sched_barrier(0);
    l_store(s1, lds + 32768, sr, sc);
    __syncthreads();
    if (kt + 3 < nk) g_load<AF32>(s1, Ab, lda, Bb, ldb, kt + 3, sr, sc);
    __builtin_amdgcn_sched_barrier(0);
    mma_step<SUMSQ>(lds + 32768, acc, wm, wn, r, hh, ss);
    __builtin_amdgcn_sched_barrier(0);
    if (kt + 2 < nk) l_store(s0, lds, sr, sc);
    __syncthreads();
  }
}

DI void acc_to_lds(const f32x16 (&acc)[2][2], float* C) {
  const int tid = otid(), lane = tid & 63, w = tid >> 6;
  const int wm = w >> 1, wn = w & 1, r = lane & 31, hh = lane >> 5;
#pragma unroll
  for (int mi = 0; mi < 2; ++mi)
#pragma unroll
    for (int ni = 0; ni < 2; ++ni)
#pragma unroll
      for (int g = 0; g < 16; ++g) C[(wm * 64 + mi * 32 + crow(g, hh)) * 132 + wn * 64 + ni * 32 + r] = acc[mi][ni][g];
}
DI void ss_to_rstd(const float (&ss)[4], float* rstd, float invK) {
  const int tid = otid(), lane = tid & 63, w = tid >> 6;
  const int wm = w >> 1, wn = w & 1, r = lane & 31, hh = lane >> 5;
#pragma unroll
  for (int i = 0; i < 2; ++i) {
    float s = ss[i];
    s += __shfl_xor(s, 32);
    if (wn == 0 && hh == 0) rstd[wm * 64 + i * 32 + r] = rsqrtf(s * invK + 1e-6f);
  }
}

DI int seq_pos(int round, int vb) {
  const int G = vgrid();
  if (G != 512) return round * G + vbid();
  return (round * 8 + (vb >> 6)) * 64 + (vb & 63);
}
DI void pos_to_tile(int s, int MTn, int NTn, int SH, int& mt, int& nt) {
  const int strip_sz = SH * NTn;
  const int strip = s / strip_sz; const int w = s - strip * strip_sz;
  const int hgt = min(SH, MTn - strip * SH);
  nt = w / hgt; mt = strip * SH + (w - nt * hgt);
}

DI void transpose_item(const float* __restrict__ src, int K, int N, const float* __restrict__ g, u16* __restrict__ dst, int k0, int n0, float* L) {
  const int tid = otid();
#pragma unroll
  for (int i = 0; i < 4; ++i) {
    const int kk = i * 16 + (tid >> 4), n4 = (tid & 15) * 4;
    float4 v = make_float4(0.f, 0.f, 0.f, 0.f);
    if (n0 + n4 < N) {
      v = *(const float4*)(src + (size_t)(k0 + kk) * N + n0 + n4);
      if (g) { const float gg = g[k0 + kk]; v.x *= gg; v.y *= gg; v.z *= gg; v.w *= gg; }
    }
    L[kk * 65 + n4] = v.x; L[kk * 65 + n4 + 1] = v.y; L[kk * 65 + n4 + 2] = v.z; L[kk * 65 + n4 + 3] = v.w;
  }
  __syncthreads();
  {
    const int n = tid >> 2, kq = tid & 3;
    float v[16];
#pragma unroll
    for (int j = 0; j < 16; ++j) v[j] = L[(kq * 16 + j) * 65 + n];
    uint4* d = (uint4*)(dst + (size_t)(n0 + n) * K + k0 + kq * 16);
    d[0] = pk8(v); d[1] = pk8(v + 8);
  }
  __syncthreads();
}

DI void phase0(const Params& p, char* lds) {
  const int tid = otid();
  u16* win = (u16*)(p.ws + W_WIN); u16* wout = (u16*)(p.ws + W_WOUT); u16* wpg = (u16*)(p.ws + W_WPG); u16* wpe = (u16*)(p.ws + W_WPE);
  for (int it = vbid(); it < DEPTH * 1312; it += vgrid()) {
    const int l = it / 1312; int j = it % 1312;
    if (j < 736) { transpose_item(p.w_in + (size_t)l * DM * NIN, DM, NIN, p.norm_g + l * DM, win + (size_t)l * NINP * DM, (j / 46) * 64, (j % 46) * 64, (float*)lds); }
    else if (j < 992) { j -= 736; transpose_item(p.w_out + (size_t)l * DM * DM, DM, DM, nullptr, wout + (size_t)l * DM * DM, (j / 16) * 64, (j % 16) * 64, (float*)lds); }
    else if (j < 1248) { j -= 992; transpose_item(p.w_pg + (size_t)l * DM * DM, DM, DM, p.pe_norm_g + l * DM, wpg + (size_t)l * DM * DM, (j / 16) * 64, (j % 16) * 64, (float*)lds); }
    else { j -= 1248; transpose_item(p.w_pe + (size_t)l * DPLE * DM, DPLE, DM, nullptr, wpe + (size_t)l * DM * DPLE, (j / 16) * 64, (j % 16) * 64, (float*)lds); }
  }
  u16* hb = (u16*)(p.ws + W_MIX);
  float* ssA = (float*)(p.ws + W_SSA);
  const size_t gt = (size_t)vbid() * NTHR + tid, gs = (size_t)vgrid() * NTHR;
  for (int row = vbid() * 4 + (tid >> 6); row < TT; row += vgrid() * 4) {
    const int lane = tid & 63;
    const float* s = (row < TP ? p.x_prompt + (size_t)row * DM : p.x_sample + (size_t)(row - TP) * DM) + lane * 8;
    float sq = 0.f;
#pragma unroll
    for (int hf = 0; hf < 2; ++hf) {
      const float4 f0 = *(const float4*)(s + hf * 512), f1 = *(const float4*)(s + hf * 512 + 4);
      sq += f0.x * f0.x + f0.y * f0.y + f0.z * f0.z + f0.w * f0.w + f1.x * f1.x + f1.y * f1.y + f1.z * f1.z + f1.w * f1.w;
      *(uint4*)(hb + (size_t)row * DM + hf * 512 + lane * 8) = make_uint4(pk2(f0.x, f0.y), pk2(f0.z, f0.w), pk2(f1.x, f1.y), pk2(f1.z, f1.w));
    }
    sq += __shfl_xor(sq, 1); sq += __shfl_xor(sq, 2); sq += __shfl_xor(sq, 4); sq += __shfl_xor(sq, 8); sq += __shfl_xor(sq, 16); sq += __shfl_xor(sq, 32);
    if (lane == 0) ssA[row] = sq;
  }
  float* rope = (float*)(p.ws + W_ROPE);
  for (size_t i = gt; i < (size_t)TP * 8; i += gs) {
    const int pos = (int)(i >> 3), fi = (int)(i & 7);
    float inv = 1.0f;
    switch (fi) {
      case 1: inv = 0.1939227432012558f; break; case 2: inv = 0.03760603070259094f; break; case 3: inv = 0.007292664609849453f; break;
      case 4: inv = 0.0014142135623842478f; break; case 5: inv = 0.00027424818836152554f; break; case 6: inv = 5.3182957344688475e-05f; break;
      case 7: inv = 1.0313385246263351e-05f; break; default: break;
    }
    const float angf = (float)pos * inv;
    const double a = (double)angf;
    const double q = rint(a * 0.63661977236758134308);
    double rr = fma(-q, 1.57079632679489655800e+00, a);
    rr = fma(-q, 6.12323399573676603587e-17, rr);
    const double r2 = rr * rr;
    const double sn = rr * (1.0 + r2 * (-1.0 / 6 + r2 * (1.0 / 120 + r2 * (-1.0 / 5040 + r2 * (1.0 / 362880 + r2 * (-1.0 / 39916800))))));
    const double cs = 1.0 + r2 * (-0.5 + r2 * (1.0 / 24 + r2 * (-1.0 / 720 + r2 * (1.0 / 40320 + r2 * (-1.0 / 3628800 + r2 * (1.0 / 479001600))))));
    const int qi = ((int)q) & 3;
    double c, s;
    if (qi == 0) { c = cs; s = sn; } else if (qi == 1) { c = -sn; s = cs; } else if (qi == 2) { c = -cs; s = -sn; } else { c = sn; s = -cs; }
    rope[pos * 16 + fi] = (float)c;
    rope[pos * 16 + 8 + fi] = (float)s;
  }
}

DI void store_rows_bf16(const float* C, const float* rstd, u16* dst, int ld, int m0, int coloff, float scale, bool silu) {
  const int tid = otid();
#pragma unroll 1
  for (int it = 0; it < 8; ++it) {
    const int item = it * 256 + tid, row = item >> 4, cgp = item & 15;
    const float rs = rstd[row] * scale;
    float v[8];
    const float4 a = *(const float4*)(C + row * 132 + cgp * 8), b = *(const float4*)(C + row * 132 + cgp * 8 + 4);
    v[0] = a.x * rs; v[1] = a.y * rs; v[2] = a.z * rs; v[3] = a.w * rs; v[4] = b.x * rs; v[5] = b.y * rs; v[6] = b.z * rs; v[7] = b.w * rs;
    if (silu) {
#pragma unroll
      for (int j = 0; j < 8; ++j) v[j] = siluf_(v[j]);
    }
    *(uint4*)(dst + (size_t)(m0 + row) * ld + coloff + cgp * 8) = pk8(v);
  }
}
DI void store_cols_bf16T(const float* C, const float* rstd, u16* dstT, int m0, int colbase) {
  const int tid = otid();
#pragma unroll 1
  for (int it = 0; it < 8; ++it) {
    const int item = it * 256 + tid, col = item & 127, rg = item >> 7;
    float v[8];
#pragma unroll
    for (int j = 0; j < 8; ++j) v[j] = C[(rg * 8 + j) * 132 + col] * rstd[rg * 8 + j];
    *(uint4*)(dstT + (size_t)(colbase + col) * TPS + m0 + rg * 8) = pk8(v);
  }
}
DI void store_rows_f32_kv(const float* C, const float* rstd, float* out, size_t off_p, size_t off_s, int l, int m0) {
  const int tid = otid();
#pragma unroll 1
  for (int it = 0; it < 8; ++it) {
    const int item = it * 256 + tid, row = item >> 4, cgp = item & 15;
    const int grow = m0 + row;
    float* d;
    if (grow >= TP) d = out + off_s + ((size_t)l * TS + (grow - TP)) * 128;
    else if (grow >= TP - 128) d = out + off_p + ((size_t)l * 128 + (grow - (TP - 128))) * 128;
    else continue;
    const float rs = rstd[row];
    const float4 a = *(const float4*)(C + row * 132 + cgp * 8), b = *(const float4*)(C + row * 132 + cgp * 8 + 4);
    *(float4*)(d + cgp * 8) = make_float4(a.x * rs, a.y * rs, a.z * rs, a.w * rs);
    *(float4*)(d + cgp * 8 + 4) = make_float4(b.x * rs, b.y * rs, b.z * rs, b.w * rs);
  }
}

DI void phaseA(const Params& p, int l, char* lds, int vb) {
  const int tid = otid();
  float* C = (float*)lds;
  float* rstd = (float*)(lds + 128 * 132 * 4);
  const u16* hb = (const u16*)(p.ws + W_MIX);
  const u16* wt = (const u16*)(p.ws + W_WIN) + (size_t)l * NINP * DM;
  const float* rope = (const float*)(p.ws + W_ROPE);
  const float* ssA = (const float*)(p.ws + W_SSA);
  { float* ssD = (float*)(p.ws + W_SSD); for (int i = vbid() * NTHR + tid; i < TT; i += vgrid() * NTHR) ssD[i] = 0.f; }
  for (int rnd = 0;; ++rnd) {
    const int spos = seq_pos(rnd, vb);
    if (rnd * vgrid() >= MT * 23) break;
    if (spos >= MT * 23) continue;
    int mt, nt; pos_to_tile(spos, MT, 23, 8, mt, nt);
    const int m0 = mt * 128, n0 = nt * 128;
    f32x16 acc[2][2];
    for (int i = 0; i < 2; ++i) for (int j = 0; j < 2; ++j) acc[i][j] = zero16();
    float ss[4] = {0.f, 0.f, 0.f, 0.f};
    gemm_main<false, false>(hb + (size_t)m0 * DM, DM, wt + (size_t)n0 * DM, DM, DM, acc, lds, ss);
    acc_to_lds(acc, C);
    if (tid < 128) rstd[tid] = rsqrtf(ssA[m0 + tid] * (1.f / DM) + 1e-6f);
    __syncthreads();
    if (n0 < 640) {
      const bool isq = n0 < 512;
      const float* gn = (isq ? p.q_norm_g : p.k_norm_g) + l * 64;
#pragma unroll 1
      for (int it = 0; it < 8; ++it) {
        const int item = it * 256 + tid, row = item >> 4, cgp = item & 15;
        const int grow = m0 + row, d0 = (cgp & 7) * 8;
        const float rs = rstd[row];
        float v[8];
        const float4 a = *(const float4*)(C + row * 132 + cgp * 8), b = *(const float4*)(C + row * 132 + cgp * 8 + 4);
        v[0] = a.x * rs; v[1] = a.y * rs; v[2] = a.z * rs; v[3] = a.w * rs; v[4] = b.x * rs; v[5] = b.y * rs; v[6] = b.z * rs; v[7] = b.w * rs;
        float s = 0.f;
#pragma unroll
        for (int j = 0; j < 8; ++j) s += v[j] * v[j];
        s += __shfl_xor(s, 1); s += __shfl_xor(s, 2); s += __shfl_xor(s, 4);
        const float hr = rsqrtf(s * (1.f / 64) + 1e-6f);
#pragma unroll
        for (int j = 0; j < 8; ++j) v[j] = v[j] * hr * gn[d0 + j];
        const int pos = grow < TP ? grow : 1024 + ((grow - TP) & 15);
        float pr[8];
#pragma unroll
        for (int j = 0; j < 8; ++j) pr[j] = __shfl_xor(v[j], 1);
        if ((cgp & 7) < 2) {
          const float4 c0 = *(const float4*)(rope + pos * 16), c1 = *(const float4*)(rope + pos * 16 + 4);
          const float4 s0 = *(const float4*)(rope + pos * 16 + 8), s1 = *(const float4*)(rope + pos * 16 + 12);
          const float cs[8] = {c0.x, c0.y, c0.z, c0.w, c1.x, c1.y, c1.z, c1.w};
          const float sn[8] = {s0.x, s0.y, s0.z, s0.w, s1.x, s1.y, s1.z, s1.w};
          const float sg = ((cgp & 7) == 0) ? -1.f : 1.f;
#pragma unroll
          for (int j = 0; j < 8; ++j) v[j] = v[j] * cs[j] + sg * pr[j] * sn[j];
        }
        if (isq) {
#pragma unroll
          for (int j = 0; j < 8; ++j) v[j] *= 0.125f;
          *(uint4*)((u16*)(p.ws + W_Q) + (size_t)grow * 512 + n0 + cgp * 8) = pk8(v);
        } else {
          *(uint4*)((u16*)(p.ws + W_K) + (size_t)grow * 128 + cgp * 8) = pk8(v);
          float* d = nullptr;
          if (grow >= TP) d = p.out + O_KS + ((size_t)l * TS + (grow - TP)) * 128;
          else if (grow >= TP - 128) d = p.out + O_KP + ((size_t)l * 128 + (grow - (TP - 128))) * 128;
          if (d) {
            *(float4*)(d + cgp * 8) = make_float4(v[0], v[1], v[2], v[3]);
            *(float4*)(d + cgp * 8 + 4) = make_float4(v[4], v[5], v[6], v[7]);
          }
        }
      }
    } else if (n0 == 640) {
      if (m0 < TP) store_cols_bf16T(C, rstd, (u16*)(p.ws + W_VT), m0, 0);
      if (m0 >= TP - 128) store_rows_f32_kv(C, rstd, p.out, O_VP, O_VS, l, m0);
    } else if (n0 < 1280) {
      store_rows_bf16(C, rstd, (u16*)(p.ws + W_GATE), DM, m0, n0 - 768, 1.f, true);
    } else if (n0 < 1536) {
      store_rows_bf16(C, rstd, (u16*)(p.ws + W_QB), 256, m0, n0 - 1280, 0.125f, false);
    } else if (n0 < 1792) {
      store_rows_bf16(C, rstd, (u16*)(p.ws + W_KB), 256, m0, n0 - 1536, 1.f, false);
      if (m0 < TP) store_cols_bf16T(C, rstd, (u16*)(p.ws + W_KBT), m0, n0 - 1536);
    } else if (n0 < 2304) {
      if (m0 < TP) store_cols_bf16T(C, rstd, (u16*)(p.ws + W_VBT), m0, n0 - 1792);
      else store_rows_bf16(C, rstd, (u16*)(p.ws + W_VBS), 512, m0 - TP, n0 - 1792, 1.f, false);
    } else if (n0 < 2816) {
      store_rows_bf16(C, rstd, (u16*)(p.ws + W_GATE), DM, m0, 512 + n0 - 2304, 1.f, true);
    } else {
      float* ab = (float*)(p.ws + W_AB);
      for (int item = tid; item < 128 * 4; item += 256) {
        const int row = item >> 2, c4 = item & 3;
        const float rs = rstd[row];
        const float4 a = *(const float4*)(C + row * 132 + c4 * 4);
        *(float4*)(ab + (size_t)(m0 + row) * 16 + c4 * 4) = make_float4(a.x * rs, a.y * rs, a.z * rs, a.w * rs);
      }
    }
    __syncthreads();
  }
}

namespace pg8 {
typedef float f32x4 __attribute__((ext_vector_type(4)));
constexpr int BM = 256, BK = 64, HALF = 128, HTB = HALF * BK * 2  , STAGE_BYTES = 8 * HTB, NXCD = 8, WGM = 8;
DI int lds_byte(int r, int c) { const int st = (r >> 4) * 2 + (c >> 5), rr = r & 15, cc = c & 31, ob = rr * 64 + cc * 2; return st * 1024 + (ob ^ (((ob >> 9) & 1) << 5)); }
DI void stage_rc(int b, int& R, int& C) { const int st = b / 1024, sb = b % 1024, swz = sb ^ (((sb >> 9) & 1) << 5); R = (st >> 1) * 16 + swz / 64; C = (st & 1) * 32 + (swz % 64) / 2; }
DI int perm32(int rho) { const int n = rho >> 4, i = rho & 15; return 8 * (i >> 2) + 4 * n + (i & 3); }
struct Unit { int pm, pn; };
struct Gemm { const u16* A; const u16* Bt; int M, N, K; };
struct StaticOrder {
  int nM, nN, nwg, G, c;
  DI void init(int M, int N, int G_, int c_) { nM = M / BM; nN = N / BM; nwg = nM * nN; G = G_; c = c_; }
  DI bool next(int i, Unit& u) const {
    const long L = (long)i * G + c; if (L >= nwg) return false;
    int wgid = (int)L; { const int q = nwg / NXCD, r = nwg % NXCD, xcd = wgid % NXCD, off = wgid / NXCD; wgid = (xcd < r ? xcd * (q + 1) : r * (q + 1) + (xcd - r) * q) + off; }
    const int nig = WGM * nN, gid = wgid / nig, fm = gid * WGM, gsz = (nM - fm) < WGM ? (nM - fm) : WGM;
    u.pm = fm + ((wgid % nig) % gsz); u.pn = (wgid % nig) / gsz; return true;
  }
};
template <class Epi>
DI void gemm_phase(LAS unsigned char* lds, const Gemm g, const StaticOrder& S, const Epi& E) {
  int tid_ = threadIdx.x; asm volatile("" : "+v"(tid_));
  const int tid = tid_, wid = __builtin_amdgcn_readfirstlane(tid >> 6), lane = tid & 63, wr = wid >> 2, wc = wid & 3, fr = lane & 15, fq = lane >> 4;
  const int K = g.K, nt = K / BK;
  unsigned voffA[2], voffB0[2];
#pragma unroll
  for (int i = 0; i < 2; ++i) { int R, C; stage_rc(tid * 16 + i * 8192, R, C); const int Rb = 64 * (R >> 5) + perm32(R & 31);
    voffA[i] = (unsigned)(R * K + C) * 2u; voffB0[i] = (unsigned)(Rb * K + C) * 2u; }
  const size_t b1off = (size_t)32 * K * 2;
  const size_t kstep = (size_t)(BK * 2);
  const size_t hstep = (size_t)HALF * K * 2;
  const size_t tstep = 2 * hstep;
  const unsigned ldsw = (unsigned)wid * 1024u;
  const int aoff = lds_byte(wr * 64 + fr, fq * 8), boff = lds_byte(wc * 32 + fr, fq * 8);
#define PG8_SA(b, h) (((b) * 2 + (h)) * HTB)
#define PG8_SB(b, h) ((4 + (b) * 2 + (h)) * HTB)
#define PG8_STAGE(bufoff, gbase, voff) do { _Pragma("unroll") for (int _i = 0; _i < 2; ++_i) \
    __builtin_amdgcn_global_load_lds((const unsigned*)((const char*)(gbase) + (voff)[_i]), (LAS unsigned*)(lds + (bufoff) + ldsw + _i * 8192), 16, 0, 0); } while (0)
#define PG8_LDA(dst, b, h) do { _Pragma("unroll") for (int m = 0; m < 4; ++m) _Pragma("unroll") for (int k = 0; k < 2; ++k) dst[m][k] = *(const LAS bf16x8*)(lds + PG8_SA(b, h) + aoff + m * 2048 + k * 1024); } while (0)
#define PG8_LDB(dst, b, h) do { _Pragma("unroll") for (int n = 0; n < 2; ++n) _Pragma("unroll") for (int k = 0; k < 2; ++k) dst[n][k] = *(const LAS bf16x8*)(lds + PG8_SB(b, h) + boff + n * 2048 + k * 1024); } while (0)
#define PG8_MMA(ai, bj, At, Bt) do { __builtin_amdgcn_s_setprio(1); _Pragma("unroll") for (int m = 0; m < 4; ++m) _Pragma("unroll") for (int n = 0; n < 2; ++n) _Pragma("unroll") for (int k = 0; k < 2; ++k) \
    acc[ai][bj][m][n] = __builtin_amdgcn_mfma_f32_16x16x32_bf16(Bt[n][k], At[m][k], acc[ai][bj][m][n], 0, 0, 0); __builtin_amdgcn_s_setprio(0); } while (0)
#define PG8_WAIT_V(n) asm volatile("s_waitcnt vmcnt(" #n ")" ::: "memory")
#define PG8_WAIT_L(n) asm volatile("s_waitcnt lgkmcnt(" #n ")" ::: "memory")
#define PG8_BAR __builtin_amdgcn_s_barrier()
#define PG8_SCHED __builtin_amdgcn_sched_barrier(0)
  Unit cur, nxt; int ui = 0;
  if (!S.next(0, cur)) return;
  f32x4 acc[2][2][4][2];
#pragma unroll
  for (int a = 0; a < 2; ++a)
#pragma unroll
    for (int b = 0; b < 2; ++b)
#pragma unroll
      for (int m = 0; m < 4; ++m)
#pragma unroll
        for (int n = 0; n < 2; ++n) acc[a][b][m][n] = (f32x4){0.f, 0.f, 0.f, 0.f};
  bf16x8 At[4][2], B0[2][2], B1[2][2];
  const char* cA = (const char*)g.A + (size_t)cur.pm * tstep; const char* cB = (const char*)g.Bt + (size_t)cur.pn * tstep;
  PG8_STAGE(PG8_SB(0, 0), cB, voffB0); PG8_STAGE(PG8_SA(0, 0), cA, voffA); PG8_STAGE(PG8_SB(0, 1), cB + b1off, voffB0); PG8_STAGE(PG8_SA(0, 1), cA + hstep, voffA);
  if (wr == 1) PG8_BAR;
  PG8_WAIT_V(4); PG8_BAR;
  PG8_STAGE(PG8_SB(1, 0), cB + kstep, voffB0); PG8_STAGE(PG8_SA(1, 0), cA + kstep, voffA); PG8_STAGE(PG8_SB(1, 1), cB + kstep + b1off, voffB0);
  PG8_WAIT_V(6); PG8_BAR;
  for (;;) {
    const bool has_next = S.next(ui + 1, nxt);
    const char* nA = has_next ? (const char*)g.A + (size_t)nxt.pm * tstep : cA; const char* nB = has_next ? (const char*)g.Bt + (size_t)nxt.pn * tstep : cB;
    for (int t = 0; t < nt; t += 2) {
      const bool last = (t == nt - 2);
      const char* a1 = cA + (size_t)(t + 1) * kstep;
      const char* a2 = last ? nA : cA + (size_t)(t + 2) * kstep; const char* b2 = last ? nB : cB + (size_t)(t + 2) * kstep;
      const char* a3 = a2 + kstep; const char* b3 = b2 + kstep;
      PG8_LDB(B0, 0, 0); PG8_SCHED; PG8_LDA(At, 0, 0); PG8_STAGE(PG8_SA(1, 1), a1 + hstep, voffA);
      PG8_WAIT_L(8); PG8_BAR; PG8_WAIT_L(0); PG8_MMA(0, 0, At, B0); PG8_BAR; PG8_SCHED;
      PG8_LDB(B1, 0, 1); PG8_STAGE(PG8_SB(0, 0), b2, voffB0);
      PG8_BAR; PG8_WAIT_L(0); PG8_MMA(0, 1, At, B1); PG8_BAR;
      PG8_LDA(At, 0, 1); PG8_STAGE(PG8_SA(0, 0), a2, voffA);
      PG8_BAR; PG8_WAIT_L(0); PG8_MMA(1, 0, At, B0); PG8_BAR; PG8_SCHED;
      PG8_STAGE(PG8_SB(0, 1), b2 + b1off, voffB0);
      PG8_WAIT_V(6); PG8_BAR; PG8_MMA(1, 1, At, B1); PG8_BAR;
      PG8_LDB(B0, 1, 0); PG8_SCHED; PG8_LDA(At, 1, 0); PG8_STAGE(PG8_SA(0, 1), a2 + hstep, voffA);
      PG8_WAIT_L(8); PG8_BAR; PG8_WAIT_L(0); PG8_MMA(0, 0, At, B0); PG8_BAR; PG8_SCHED;
      PG8_LDB(B1, 1, 1); PG8_STAGE(PG8_SB(1, 0), b3, voffB0);
      PG8_BAR; PG8_WAIT_L(0); PG8_MMA(0, 1, At, B1); PG8_BAR;
      PG8_LDA(At, 1, 1); PG8_STAGE(PG8_SA(1, 0), a3, voffA);
      PG8_BAR; PG8_WAIT_L(0); PG8_MMA(1, 0, At, B0); PG8_BAR; PG8_SCHED;
      PG8_STAGE(PG8_SB(1, 1), b3 + b1off, voffB0);
      PG8_WAIT_V(6); PG8_BAR; PG8_MMA(1, 1, At, B1); PG8_BAR;
    }
    E(acc, cur, wr, wc, fr, fq);
    if (!has_next) break;
#pragma unroll
    for (int a = 0; a < 2; ++a)
#pragma unroll
      for (int b = 0; b < 2; ++b)
#pragma unroll
        for (int m = 0; m < 4; ++m)
#pragma unroll
          for (int n = 0; n < 2; ++n) acc[a][b][m][n] = (f32x4){0.f, 0.f, 0.f, 0.f};
    cur = nxt; cA = nA; cB = nB; ++ui;
  }
  PG8_WAIT_V(0);
  if (wr == 0) PG8_BAR;
  PG8_BAR;
#undef PG8_SA
#undef PG8_SB
#undef PG8_STAGE
#undef PG8_LDA
#undef PG8_LDB
#undef PG8_MMA
#undef PG8_WAIT_V
#undef PG8_WAIT_L
#undef PG8_BAR
#undef PG8_SCHED
}
}

DI u16 bf1(float x) { return (u16)(pk2(x, 0.f) & 0xffffu); }
struct EpiA {
  char* ws; float* out; const float* qng; const float* kng; int l;
  template <int SEG>
  DI void rows(const pg8::f32x4 (&acc)[2][2][4][2], const pg8::Unit& u, int cb, int wr, int fr, int fq) const {
    const float* ssA = (const float*)(ws + W_SSA);
    const bool sample = u.pm >= TP / 256;
    const int c0 = 8 * fq;
    float rsv[8];
#pragma unroll
    for (int i = 0; i < 8; ++i) rsv[i] = ssA[u.pm * 256 + (i >> 2) * 128 + wr * 64 + (i & 3) * 16 + fr];
#pragma unroll
    for (int i = 0; i < 8; ++i) rsv[i] = rsqrtf(rsv[i] * (1.f / DM) + 1e-6f);
#pragma unroll
    for (int ai = 0; ai < 2; ++ai)
#pragma unroll
      for (int m = 0; m < 4; ++m) {
        const int row = u.pm * 256 + ai * 128 + wr * 64 + m * 16 + fr;
        const float rs = rsv[ai * 4 + m];
        float x[2][8];
#pragma unroll
        for (int bj = 0; bj < 2; ++bj)
#pragma unroll
          for (int n = 0; n < 2; ++n)
#pragma unroll
            for (int j = 0; j < 4; ++j) x[bj][4 * n + j] = acc[ai][bj][m][n][j] * rs;
        if (SEG < 2) {
          float sq = 0.f;
#pragma unroll
          for (int bj = 0; bj < 2; ++bj)
#pragma unroll
            for (int e = 0; e < 8; ++e) sq += x[bj][e] * x[bj][e];
          sq += __shfl_xor(sq, 16); sq += __shfl_xor(sq, 32);
          const float hr = rsqrtf(sq * (1.f / 64) + 1e-6f);
          const float* gp = (SEG == 0 ? qng : kng) + c0;
#pragma unroll
          for (int bj = 0; bj < 2; ++bj) {
            const float4 a = *(const float4*)(gp + 32 * bj), b = *(const float4*)(gp + 32 * bj + 4);
            x[bj][0] *= hr * a.x; x[bj][1] *= hr * a.y; x[bj][2] *= hr * a.z; x[bj][3] *= hr * a.w;
            x[bj][4] *= hr * b.x; x[bj][5] *= hr * b.y; x[bj][6] *= hr * b.z; x[bj][7] *= hr * b.w;
          }
          const int pos = row < TP ? row : 1024 + ((row - TP) & 15);
          const float* rp = (const float*)(ws + W_ROPE) + pos * 16;
          float rpc[16];
#pragma unroll
          for (int e = 0; e < 16; e += 4) { const float4 t = *(const float4*)(rp + e); rpc[e] = t.x; rpc[e + 1] = t.y; rpc[e + 2] = t.z; rpc[e + 3] = t.w; }
          const float sg = fq == 0 ? -1.f : 1.f;
#pragma unroll
          for (int e = 0; e < 8; ++e) {
            const float pr = __shfl_xor(x[0][e], 16);
            if (fq < 2) x[0][e] = x[0][e] * rpc[e] + sg * pr * rpc[8 + e];
          }
          if (SEG == 0) {
#pragma unroll
            for (int bj = 0; bj < 2; ++bj) {
#pragma unroll
              for (int e = 0; e < 8; ++e) x[bj][e] *= 0.125f;
              *(uint4*)((u16*)(ws + W_Q) + (size_t)row * 512 + cb + 32 * bj + c0) = pk8(x[bj]);
            }
          } else {
            const int kc = cb - 512;
            float* d = nullptr;
            if (row >= TP) d = out + O_KS + ((size_t)l * TS + (row - TP)) * 128;
            else if (row >= TP - 128) d = out + O_KP + ((size_t)l * 128 + (row - (TP - 128))) * 128;
#pragma unroll
            for (int bj = 0; bj < 2; ++bj) {
              *(uint4*)((u16*)(ws + W_K) + (size_t)row * 128 + kc + 32 * bj + c0) = pk8(x[bj]);
              if (d) { *(float4*)(d + kc + 32 * bj + c0) = make_float4(x[bj][0], x[bj][1], x[bj][2], x[bj][3]); *(float4*)(d + kc + 32 * bj + c0 + 4) = make_float4(x[bj][4], x[bj][5], x[bj][6], x[bj][7]); }
            }
          }
        } else if (SEG == 2) {
          const int vc = cb - 640;
          float* d = nullptr;
          if (row >= TP) d = out + O_VS + ((size_t)l * TS + (row - TP)) * 128;
          else if (row >= TP - 128) d = out + O_VP + ((size_t)l * 128 + (row - (TP - 128))) * 128;
#pragma unroll
          for (int bj = 0; bj < 2; ++bj) {
            if (!sample) {
              u16* vT = (u16*)(ws + W_VT) + tidx(128, vc + 32 * bj + c0, row);
#pragma unroll
              for (int e = 0; e < 8; ++e) vT[e * 64] = bf1(x[bj][e]);
            }
            if (d) { *(float4*)(d + vc + 32 * bj + c0) = make_float4(x[bj][0], x[bj][1], x[bj][2], x[bj][3]); *(float4*)(d + vc + 32 * bj + c0 + 4) = make_float4(x[bj][4], x[bj][5], x[bj][6], x[bj][7]); }
          }
        } else if (SEG == 3 || SEG == 7) {
          const int gc = SEG == 3 ? cb - 768 : 512 + cb - 2304;
#pragma unroll
          for (int bj = 0; bj < 2; ++bj) {
#pragma unroll
            for (int e = 0; e < 8; ++e) x[bj][e] = siluf_(x[bj][e]);
            *(uint4*)((u16*)(ws + W_GATE) + (size_t)row * DM + gc + 32 * bj + c0) = pk8(x[bj]);
          }
        } else if (SEG == 4) {
#pragma unroll
          for (int bj = 0; bj < 2; ++bj) {
#pragma unroll
            for (int e = 0; e < 8; ++e) x[bj][e] *= 0.125f;
            *(uint4*)((u16*)(ws + W_QB) + (size_t)row * 256 + (cb - 1280) + 32 * bj + c0) = pk8(x[bj]);
          }
        } else if (SEG == 5) {
#pragma unroll
          for (int bj = 0; bj < 2; ++bj) {
            *(uint4*)((u16*)(ws + W_KB) + (size_t)row * 256 + (cb - 1536) + 32 * bj + c0) = pk8(x[bj]);
            if (!sample) {
              u16* kT = (u16*)(ws + W_KBT) + tidx(256, cb - 1536 + 32 * bj + c0, row);
#pragma unroll
              for (int e = 0; e < 8; ++e) kT[e * 64] = bf1(x[bj][e]);
            }
          }
        } else {
#pragma unroll
          for (int bj = 0; bj < 2; ++bj) {
            if (!sample) {
              u16* vT = (u16*)(ws + W_VBT) + tidx(512, cb - 1792 + 32 * bj + c0, row);
#pragma unroll
              for (int e = 0; e < 8; ++e) vT[e * 64] = bf1(x[bj][e]);
            } else {
              *(uint4*)((u16*)(ws + W_VBS) + (size_t)(row - TP) * 512 + (cb - 1792) + 32 * bj + c0) = pk8(x[bj]);
            }
          }
        }
        if (m & 1) asm volatile("" ::: "memory");
      }
  }
  DI void operator()(const pg8::f32x4 (&acc)[2][2][4][2], const pg8::Unit& u, int wr, int wc, int fr, int fq) const {
    const int cb = u.pn * 256 + wc * 64;
    if (cb < 512) rows<0>(acc, u, cb, wr, fr, fq);
    else if (cb < 640) rows<1>(acc, u, cb, wr, fr, fq);
    else if (cb < 768) rows<2>(acc, u, cb, wr, fr, fq);
    else if (cb < 1280) rows<3>(acc, u, cb, wr, fr, fq);
    else if (cb < 1536) rows<4>(acc, u, cb, wr, fr, fq);
    else if (cb < 1792) rows<5>(acc, u, cb, wr, fr, fq);
    else if (cb < 2304) rows<6>(acc, u, cb, wr, fr, fq);
    else rows<7>(acc, u, cb, wr, fr, fq);
  }
};

DI void phaseA8(const Params& p, int l, char* lds_all) {
  { int t0 = threadIdx.x; asm volatile("" : "+v"(t0));
    float* ssD = (float*)(p.ws + W_SSD);
    const int per = (TT + (int)gridDim.x - 1) / (int)gridDim.x, i = (int)blockIdx.x * per + t0;
    if (t0 < per && i < TT) ssD[i] = 0.f; }
  const u16* hb = (const u16*)(p.ws + W_MIX);
  const u16* wt = (const u16*)(p.ws + W_WIN) + (size_t)l * NINP * DM;
  pg8::Gemm g{hb, wt, TT, 2816, DM};
  pg8::StaticOrder S; S.init(TT, 2816, (int)gridDim.x, obid());
  EpiA E{p.ws, p.out, p.q_norm_g + l * 64, p.k_norm_g + l * 64, l};
  pg8::gemm_phase<EpiA>((LAS unsigned char*)lds_all, g, S, E);
  {
    int t2 = threadIdx.x; asm volatile("" : "+v"(t2));
    const int wid = t2 >> 6, lane = t2 & 63, r = lane & 31, hh = lane >> 5;
    const int gw = ((int)gridDim.x - 1 - (int)blockIdx.x) * 8 + wid;
    if (gw < TT / 32) {
      const int row0 = gw * 32;
      const u16* ap = hb + (size_t)(row0 + r) * DM + 8 * hh;
      const u16* bp = wt + (size_t)(2816 + r) * DM + 8 * hh;
      f32x16 acc = zero16();
#pragma unroll 16
      for (int ks = 0; ks < 64; ++ks) acc = MFMA(*(const bf16x8*)(ap + ks * 16), *(const bf16x8*)(bp + ks * 16), acc);
      const float* ssA = (const float*)(p.ws + W_SSA);
      float* ab = (float*)(p.ws + W_AB);
      if (r < 16) {
#pragma unroll
        for (int gi = 0; gi < 16; ++gi) { const int row = row0 + crow(gi, hh); ab[(size_t)row * 16 + r] = acc[gi] * rsqrtf(ssA[row] * (1.f / DM) + 1e-6f); }
      }
    }
  }
}

DI void phaseB(const Params& p, int l, char* lds) {
  const int tid = otid(), lane = tid & 63, w = tid >> 6, r = lane & 31, hh = lane >> 5;
  float* bN = (float*)lds;
  float* bT = bN + 64 * 65;
  float* tot = bT + 64 * 68;
  float* blast = tot + 256;
  const float* ab = (const float*)(p.ws + W_AB);
  u16* qb = (u16*)(p.ws + W_QB); u16* kb = (u16*)(p.ws + W_KB);
  const u16* kbT = (const u16*)(p.ws + W_KBT); const u16* vbT = (const u16*)(p.ws + W_VBT);
  float* Sb = (float*)(p.ws + W_S); float* dec = (float*)(p.ws + W_DEC);
  { float* ssA = (float*)(p.ws + W_SSA);
    const int per = (TT + vgrid() - 1) / vgrid(), i = vbid() * per + tid;
    if (tid < per && i < TT) ssA[i] = 0.f; }
  for (int item = vbid(); item < NCH * 4; item += vgrid()) {
    const int c = item >> 2, h = item & 3;
    {
      const int k = tid & 63, g = tid >> 6;
      float wg[16];
#pragma unroll
      for (int j = 0; j < 16; ++j) wg[j] = p.w_gate_up[((size_t)l * 16 + j) * 256 + h * 64 + k];
      const float bias = p.b_gate[l * 256 + h * 64 + k];
      float loc[16]; float cum = 0.f;
#pragma unroll
      for (int i = 0; i < 16; ++i) {
        const float* a = ab + (size_t)(c * 64 + g * 16 + i) * 16;
        const float4 a0 = *(const float4*)a, a1 = *(const float4*)(a + 4), a2 = *(const float4*)(a + 8), a3 = *(const float4*)(a + 12);
        float z = bias + a0.x * wg[0] + a0.y * wg[1] + a0.z * wg[2] + a0.w * wg[3] + a1.x * wg[4] + a1.y * wg[5] + a1.z * wg[6] + a1.w * wg[7]
                  + a2.x * wg[8] + a2.y * wg[9] + a2.z * wg[10] + a2.w * wg[11] + a3.x * wg[12] + a3.y * wg[13] + a3.z * wg[14] + a3.w * wg[15];
        cum += logsigmoidf_(z) * (1.f / 16);
        loc[i] = cum;
      }
      tot[g * 64 + k] = cum;
      __syncthreads();
      float off = 0.f;
      for (int g2 = 0; g2 < g; ++g2) off += tot[g2 * 64 + k];
#pragma unroll
      for (int i = 0; i < 16; ++i) {
        const int t = g * 16 + i; const float bv = loc[i] + off;
        bN[t * 65 + k] = bv; bT[k * 68 + t] = bv;
      }
      if (g == 3) { const float bl = loc[15] + off; blast[k] = bl; dec[(size_t)item * 64 + k] = __expf(bl); }
      __syncthreads();
    }
#pragma unroll
    for (int i = 0; i < 2; ++i) {
      const int grp = tid + 256 * i, t = grp >> 3, kc = grp & 7;
      const size_t off = (size_t)(c * 64 + t) * 256 + h * 64 + kc * 8;
      float qv[8], kv[8];
      unpk8(*(const uint4*)(qb + off), qv); unpk8(*(const uint4*)(kb + off), kv);
#pragma unroll
      for (int j = 0; j < 8; ++j) { const float bb = bN[t * 65 + kc * 8 + j]; qv[j] *= __expf(bb); kv[j] *= __expf(-bb); }
      *(uint4*)(qb + off) = pk8(qv); *(uint4*)(kb + off) = pk8(kv);
    }
    {
      f32x16 acc[2] = {zero16(), zero16()};
#pragma unroll
      for (int s = 0; s < 4; ++s) {
        const int t0 = 16 * s + 8 * hh;
        const bf16x8 vf = *(const bf16x8*)(vbT + tidx(512, h * 128 + w * 32 + r, c * 64 + t0));
#pragma unroll
        for (int kt = 0; kt < 2; ++kt) {
          const int k = kt * 32 + r;
          float kv[8];
          unpk8(*(const uint4*)(kbT + tidx(256, h * 64 + k, c * 64 + t0)), kv);
          const float bl = blast[k];
          const float4 b0 = *(const float4*)(bT + k * 68 + t0), b1 = *(const float4*)(bT + k * 68 + t0 + 4);
          kv[0] *= __expf(bl - b0.x); kv[1] *= __expf(bl - b0.y); kv[2] *= __expf(bl - b0.z); kv[3] *= __expf(bl - b0.w);
          kv[4] *= __expf(bl - b1.x); kv[5] *= __expf(bl - b1.y); kv[6] *= __expf(bl - b1.z); kv[7] *= __expf(bl - b1.w);
          acc[kt] = MFMA(vf, as_frag(pk8(kv)), acc[kt]);
        }
      }
#pragma unroll
      for (int kt = 0; kt < 2; ++kt)
#pragma unroll
        for (int g = 0; g < 16; ++g) Sb[(size_t)item * 8192 + (size_t)(w * 32 + crow(g, hh)) * 64 + kt * 32 + r] = acc[kt][g];
    }
    __syncthreads();
  }
}

DI void scan_item(const Params& p, int l, int it) {
  const int e = it * 256 + otid();
  const int h = e >> 13, v = (e >> 6) & 127, k = e & 63;
  float* Sb = (float*)(p.ws + W_S) + e;
  const float* dec = (const float*)(p.ws + W_DEC) + h * 64 + k;
  float S = 0.f;
  for (int c0 = 0; c0 < NCH; c0 += 16) {
    float d[16], g[16];
#pragma unroll
    for (int j = 0; j < 16; ++j) { d[j] = Sb[(size_t)(c0 + j) * 32768]; g[j] = dec[(size_t)(c0 + j) * 256]; }
#pragma unroll
    for (int j = 0; j < 16; ++j) { Sb[(size_t)(c0 + j) * 32768] = S; S = g[j] * S + d[j]; }
  }
  p.out[O_SP + (size_t)l * 32768 + h * 8192 + k * 128 + v] = S;
}

DI void attn_prompt_item(const Params& p, int l, int item, char* lds) {
  const int tid = otid(), lane = tid & 63, w = tid >> 6, r = lane & 31, hh = lane >> 5;
  const int c = item >> 2, kvh = (item >> 1) & 1, hp = item & 1;
  const int hq = kvh * 4 + hp * 2 + (w >> 1), qt = w & 1;
  const u16* q = (const u16*)(p.ws + W_Q); const u16* kbuf = (const u16*)(p.ws + W_K); const u16* vT = (const u16*)(p.ws + W_VT);
  const u16* gate = (const u16*)(p.ws + W_GATE); u16* mix = (u16*)(p.ws + W_MIX);
  const int qtok = c * 64 + qt * 32 + r;
  const int kt0 = c >= 2 ? 0 : (2 - c) * 2;
  const int kbase = (c - 2) * 64;
  char* Ks = lds;
  char* Vs = lds + 24576;
  char* Qs = lds + 49152 + w * 4096;
  {
    uint4 kr[6], vr[6], qr[4];
#pragma unroll
    for (int i = 0; i < 6; ++i) {
      const int idx = i * 256 + tid, row = idx >> 3, c16 = idx & 7;
      kr[i] = *(const uint4*)(kbuf + (size_t)max(kbase + row, 0) * 128 + kvh * 64 + c16 * 8);
      const int jc = max(c - 2 + (row >> 6), 0);
      vr[i] = *(const uint4*)(vT + ((size_t)jc * 128 + kvh * 64 + (row & 63)) * 64 + c16 * 8);
    }
#pragma unroll
    for (int i = 0; i < 4; ++i) {
      const int idx = i * 64 + lane, row = idx >> 3, c16 = idx & 7;
      qr[i] = *(const uint4*)(q + (size_t)(c * 64 + qt * 32 + row) * 512 + hq * 64 + c16 * 8);
    }
#pragma unroll
    for (int i = 0; i < 6; ++i) {
      const int idx = i * 256 + tid, row = idx >> 3, c16 = idx & 7;
      *(uint4*)(Ks + row * 128 + ((c16 ^ ((row >> 1) & 7)) << 4)) = kr[i];
      *(uint4*)(Vs + row * 128 + ((c16 ^ (row & 7)) << 4)) = vr[i];
    }
#pragma unroll
    for (int i = 0; i < 4; ++i) {
      const int idx = i * 64 + lane, row = idx >> 3, c16 = idx & 7;
      *(uint4*)(Qs + row * 128 + ((c16 ^ ((row >> 1) & 7)) << 4)) = qr[i];
    }
  }
  __syncthreads();
  bf16x8 qf[4];
#pragma unroll
  for (int ks = 0; ks < 4; ++ks) qf[ks] = *(const bf16x8*)(Qs + r * 128 + (((2 * ks + hh) ^ ((r >> 1) & 7)) << 4));
  f32x16 s[6];
  __builtin_amdgcn_s_setprio(1);
#pragma unroll
  for (int kt = 0; kt < 6; ++kt) {
    s[kt] = zero16();
    const int krow = kt * 32 + r;
#pragma unroll
    for (int ks = 0; ks < 4; ++ks) s[kt] = MFMA(*(const bf16x8*)(Ks + krow * 128 + (((2 * ks + hh) ^ ((krow >> 1) & 7)) << 4)), qf[ks], s[kt]);
  }
  __builtin_amdgcn_s_setprio(0);
  uint2 gpre[8];
#pragma unroll
  for (int i = 0; i < 8; ++i) gpre[i] = *(const uint2*)(gate + (size_t)qtok * DM + hq * 64 + (i >> 2) * 32 + 8 * (i & 3) + 4 * hh);
  const float sink = p.sinks[l * 8 + hq];
  float m = sink;
#pragma unroll
  for (int kt = 0; kt < 6; ++kt) {
    const float msk = kt >= kt0 ? 0.f : -1e30f;
#pragma unroll
    for (int g = 0; g < 16; ++g) { s[kt][g] += msk; m = fmaxf(m, s[kt][g]); }
  }
  m = fmaxf(m, __shfl_xor(m, 32));
  float den = 0.f;
#pragma unroll
  for (int kt = 0; kt < 6; ++kt) {
#pragma unroll
    for (int g = 0; g < 16; ++g) { const float e = __expf(s[kt][g] - m); s[kt][g] = e; den += e; }
  }
  den += __shfl_xor(den, 32);
  den += __expf(sink - m);
  f32x16 o[2] = {zero16(), zero16()};
  __builtin_amdgcn_s_setprio(1);
#pragma unroll
  for (int kt = 0; kt < 6; ++kt) {
#pragma unroll
    for (int s2 = 0; s2 < 2; ++s2) {
      const uint4 pf = make_uint4(pk2(s[kt][8 * s2], s[kt][8 * s2 + 1]), pk2(s[kt][8 * s2 + 2], s[kt][8 * s2 + 3]),
                                  pk2(s[kt][8 * s2 + 4], s[kt][8 * s2 + 5]), pk2(s[kt][8 * s2 + 6], s[kt][8 * s2 + 7]));
      const int slot = 8 * (kt & 1) + 4 * s2 + hh;
#pragma unroll
      for (int dt = 0; dt < 2; ++dt) {
        const int vrow = (kt >> 1) * 64 + dt * 32 + r;
        const char* vp = Vs + vrow * 128 + (slot & 1) * 8;
        const uint2 lo = *(const uint2*)(vp + ((((slot >> 1)) ^ (vrow & 7)) << 4)), hi = *(const uint2*)(vp + ((((slot >> 1) + 1) ^ (vrow & 7)) << 4));
        o[dt] = MFMA(as_frag(make_uint4(lo.x, lo.y, hi.x, hi.y)), as_frag(pf), o[dt]);
      }
    }
  }
  __builtin_amdgcn_s_setprio(0);
  const float inv = 1.f / den;
#pragma unroll
  for (int dt = 0; dt < 2; ++dt)
#pragma unroll
    for (int g4 = 0; g4 < 4; ++g4) {
      const size_t off = (size_t)qtok * DM + hq * 64 + dt * 32 + 8 * g4 + 4 * hh;
      const uint2 gv = gpre[dt * 4 + g4];
      const float o0 = o[dt][4 * g4] * inv * bflo(gv.x), o1 = o[dt][4 * g4 + 1] * inv * bfhi(gv.x);
      const float o2 = o[dt][4 * g4 + 2] * inv * bflo(gv.y), o3 = o[dt][4 * g4 + 3] * inv * bfhi(gv.y);
      *(uint2*)(mix + off) = make_uint2(pk2(o0, o1), pk2(o2, o3));
    }
  __syncthreads();
}

DI void attn_sample_item(const Params& p, int l, int item, char* lds) {
  const int tid = otid();
  const int b = item >> 3, hq = item & 7, kvh = hq >> 2;
  float* sc = (float*)lds;
  float* qs = sc + 16 * 148;
  char* Ksm = lds + 13824;
  char* Vsm = Ksm + 144 * 144;
  const int t = tid >> 4, part = tid & 15;
  const int row = TP + b * 16 + t;
  const float* ck = p.cache_k + ((size_t)(l * 32 + b) * 128) * 128 + kvh * 64;
  const float* cv = p.cache_v + ((size_t)(l * 32 + b) * 128) * 128 + kvh * 64;
  const float* nk = p.out + O_KS + ((size_t)l * TS + b * 16) * 128 + kvh * 64;
  const float* nv = p.out + O_VS + ((size_t)l * TS + b * 16) * 128 + kvh * 64;
  {
    const u16* q = (const u16*)(p.ws + W_Q) + (size_t)row * 512 + hq * 64 + part * 4;
    const uint2 u = *(const uint2*)q;
    *(float4*)(qs + t * 68 + part * 4) = make_float4(bflo(u.x), bfhi(u.x), bflo(u.y), bfhi(u.y));
    float4 kr[9], vr[9];
#pragma unroll
    for (int i = 0; i < 9; ++i) {
      const int idx = i * 256 + tid, key = idx >> 4, c4 = idx & 15;
      kr[i] = *(const float4*)((key < 128 ? ck + (size_t)key * 128 : nk + (size_t)(key - 128) * 128) + c4 * 4);
      vr[i] = *(const float4*)((key < 128 ? cv + (size_t)key * 128 : nv + (size_t)(key - 128) * 128) + c4 * 4);
    }
#pragma unroll
    for (int i = 0; i < 9; ++i) {
      const int idx = i * 256 + tid, key = idx >> 4, c4 = idx & 15;
      *(uint2*)(Ksm + key * 144 + c4 * 8) = make_uint2(pk2(kr[i].x, kr[i].y), pk2(kr[i].z, kr[i].w));
      *(uint2*)(Vsm + key * 128 + c4 * 8) = make_uint2(pk2(vr[i].x, vr[i].y), pk2(vr[i].z, vr[i].w));
    }
  }
  __syncthreads();
  {
    float a[9];
#pragma unroll
    for (int i = 0; i < 9; ++i) a[i] = 0.f;
#pragma unroll 2
    for (int d = 0; d < 64; d += 8) {
      const float4 q0 = *(const float4*)(qs + t * 68 + d), q1 = *(const float4*)(qs + t * 68 + d + 4);
#pragma unroll
      for (int i = 0; i < 9; ++i) {
        float kv[8]; unpk8(*(const uint4*)(Ksm + (part * 9 + i) * 144 + d * 2), kv);
        a[i] += q0.x * kv[0] + q0.y * kv[1] + q0.z * kv[2] + q0.w * kv[3] + q1.x * kv[4] + q1.y * kv[5] + q1.z * kv[6] + q1.w * kv[7];
      }
    }
#pragma unroll
    for (int i = 0; i < 9; ++i) sc[t * 148 + part * 9 + i] = a[i];
  }
  const float sink = p.sinks[l * 8 + hq];
  float m = sink;
#pragma unroll
  for (int i = 0; i < 9; ++i) m = fmaxf(m, sc[t * 148 + part * 9 + i]);
  m = fmaxf(m, __shfl_xor(m, 1)); m = fmaxf(m, __shfl_xor(m, 2)); m = fmaxf(m, __shfl_xor(m, 4)); m = fmaxf(m, __shfl_xor(m, 8));
  float den = 0.f;
#pragma unroll
  for (int i = 0; i < 9; ++i) { const float e = __expf(sc[t * 148 + part * 9 + i] - m); den += e; sc[t * 148 + part * 9 + i] = e; }
  den += __shfl_xor(den, 1); den += __shfl_xor(den, 2); den += __shfl_xor(den, 4); den += __shfl_xor(den, 8);
  den += __expf(sink - m);
  __syncthreads();
  float o0 = 0.f, o1 = 0.f, o2 = 0.f, o3 = 0.f;
#pragma unroll 16
  for (int key = 0; key < 144; ++key) {
    const float pw = sc[t * 148 + key];
    const uint2 vv = *(const uint2*)(Vsm + key * 128 + part * 8);
    o0 += pw * bflo(vv.x); o1 += pw * bfhi(vv.x); o2 += pw * bflo(vv.y); o3 += pw * bfhi(vv.y);
  }
  const float inv = 1.f / den;
  const size_t off = (size_t)row * DM + hq * 64 + part * 4;
  const uint2 gv = *(const uint2*)((const u16*)(p.ws + W_GATE) + off);
  o0 *= inv * bflo(gv.x); o1 *= inv * bfhi(gv.x); o2 *= inv * bflo(gv.y); o3 *= inv * bfhi(gv.y);
  *(uint2*)((u16*)(p.ws + W_MIX) + off) = make_uint2(pk2(o0, o1), pk2(o2, o3));
  __syncthreads();
}

DI void gla_out_prompt(const Params& p, int l, int item, char* lds) {
  const int tid = otid(), lane = tid & 63, w = tid >> 6, r = lane & 31, hh = lane >> 5;
  const int c = item >> 2, h = item & 3;
  const int tt = w & 1, vh = w >> 1;
  char* Qs = lds;
  char* Ks = lds + 8192;
  char* Vs = lds + 16384;
  char* Ss = lds + 32768;
  char* Gs = lds + 49152;
  float* part = (float*)(lds + 65536);
  char* Os = lds;
  const u16* qtb = (const u16*)(p.ws + W_QB); const u16* ktb = (const u16*)(p.ws + W_KB); const u16* vbT = (const u16*)(p.ws + W_VBT);
  const float* Sb = (const float*)(p.ws + W_S) + (size_t)item * 8192;
  const u16* gate = (const u16*)(p.ws + W_GATE); u16* mix = (u16*)(p.ws + W_MIX);
  {
    uint4 qr[2], kr[2], vr[4], gr[4]; float4 sr[8];
#pragma unroll
    for (int i = 0; i < 2; ++i) {
      const int idx = i * 256 + tid, row = idx >> 3, c16 = idx & 7;
      qr[i] = *(const uint4*)(qtb + (size_t)(c * 64 + row) * 256 + h * 64 + c16 * 8);
      kr[i] = *(const uint4*)(ktb + (size_t)(c * 64 + row) * 256 + h * 64 + c16 * 8);
    }
#pragma unroll
    for (int i = 0; i < 4; ++i) {
      const int idx = i * 256 + tid, row = idx >> 3, c16 = idx & 7;
      vr[i] = *(const uint4*)(vbT + ((size_t)c * 512 + h * 128 + row) * 64 + c16 * 8);
      sr[2 * i] = *(const float4*)(Sb + (size_t)row * 64 + c16 * 8); sr[2 * i + 1] = *(const float4*)(Sb + (size_t)row * 64 + c16 * 8 + 4);
      const int grow = idx >> 4, g16 = idx & 15;
      gr[i] = *(const uint4*)(gate + (size_t)(c * 64 + grow) * DM + 512 + h * 128 + g16 * 8);
    }
#pragma unroll
    for (int i = 0; i < 2; ++i) {
      const int idx = i * 256 + tid, row = idx >> 3, c16 = idx & 7;
      *(uint4*)(Qs + row * 128 + ((c16 ^ ((row >> 1) & 7)) << 4)) = qr[i];
      *(uint4*)(Ks + row * 128 + ((c16 ^ ((row >> 1) & 7)) << 4)) = kr[i];
    }
#pragma unroll
    for (int i = 0; i < 4; ++i) {
      const int idx = i * 256 + tid, row = idx >> 3, c16 = idx & 7;
      *(uint4*)(Vs + row * 128 + ((c16 ^ (row & 7)) << 4)) = vr[i];
      *(uint4*)(Ss + row * 128 + ((c16 ^ ((row >> 1) & 7)) << 4)) = make_uint4(pk2(sr[2 * i].x, sr[2 * i].y), pk2(sr[2 * i].z, sr[2 * i].w), pk2(sr[2 * i + 1].x, sr[2 * i + 1].y), pk2(sr[2 * i + 1].z, sr[2 * i + 1].w));
      *(uint4*)(Gs + idx * 16) = gr[i];
    }
  }
  __syncthreads();
  const int t = tt * 32 + r, tok = c * 64 + t;
  bf16x8 qf[4];
#pragma unroll
  for (int ks = 0; ks < 4; ++ks) qf[ks] = *(const bf16x8*)(Qs + t * 128 + (((2 * ks + hh) ^ ((t >> 1) & 7)) << 4));
  f32x16 x0 = zero16(), x1 = zero16();
#pragma unroll
  for (int ks = 0; ks < 4; ++ks) {
    x0 = MFMA(*(const bf16x8*)(Ks + r * 128 + (((2 * ks + hh) ^ ((r >> 1) & 7)) << 4)), qf[ks], x0);
    x1 = MFMA(*(const bf16x8*)(Ks + (32 + r) * 128 + (((2 * ks + hh) ^ (((32 + r) >> 1) & 7)) << 4)), qf[ks], x1);
  }
#pragma unroll
  for (int g = 0; g < 16; ++g) {
    const bool keep = crow(g, hh) <= r;
    if (tt == 0) { if (!keep) x0[g] = 0.f; x1[g] = 0.f; } else { if (!keep) x1[g] = 0.f; }
  }
  f32x16 o[2] = {zero16(), zero16()};
#pragma unroll
  for (int vt = 0; vt < 2; ++vt) {
    const int v = (2 * vh + vt) * 32 + r;
#pragma unroll
    for (int st = 0; st < 2; ++st)
#pragma unroll
      for (int s2 = 0; s2 < 2; ++s2) {
        const f32x16& xx = st == 0 ? x0 : x1;
        const uint4 pf = make_uint4(pk2(xx[8 * s2], xx[8 * s2 + 1]), pk2(xx[8 * s2 + 2], xx[8 * s2 + 3]), pk2(xx[8 * s2 + 4], xx[8 * s2 + 5]), pk2(xx[8 * s2 + 6], xx[8 * s2 + 7]));
        const int slot = 8 * st + 4 * s2 + hh;
        const char* vp = Vs + v * 128 + (slot & 1) * 8;
        const uint2 lo = *(const uint2*)(vp + (((slot >> 1) ^ (v & 7)) << 4)), hi = *(const uint2*)(vp + ((((slot >> 1) + 1) ^ (v & 7)) << 4));
        o[vt] = MFMA(as_frag(make_uint4(lo.x, lo.y, hi.x, hi.y)), as_frag(pf), o[vt]);
      }
#pragma unroll
    for (int ks = 0; ks < 4; ++ks) o[vt] = MFMA(*(const bf16x8*)(Ss + v * 128 + (((2 * ks + hh) ^ ((v >> 1) & 7)) << 4)), qf[ks], o[vt]);
  }
  float sq = 0.f;
#pragma unroll
  for (int vt = 0; vt < 2; ++vt)
#pragma unroll
    for (int g = 0; g < 16; ++g) sq += o[vt][g] * o[vt][g];
  sq += __shfl_xor(sq, 32);
  if (hh == 0) part[vh * 64 + t] = sq;
  __syncthreads();
  const float rs = rsqrtf((part[t] + part[64 + t]) * (1.f / 128) + 1e-6f);
  const float* gng = p.gla_norm_g + l * 128;
#pragma unroll
  for (int vt = 0; vt < 2; ++vt)
#pragma unroll
    for (int g4 = 0; g4 < 4; ++g4) {
      const int v0 = (2 * vh + vt) * 32 + 8 * g4 + 4 * hh;
      const uint2 gv = *(const uint2*)(Gs + t * 256 + v0 * 2);
      const float4 gn = *(const float4*)(gng + v0);
      const float o0 = o[vt][4 * g4] * rs * gn.x * bflo(gv.x), o1 = o[vt][4 * g4 + 1] * rs * gn.y * bfhi(gv.x);
      const float o2 = o[vt][4 * g4 + 2] * rs * gn.z * bflo(gv.y), o3 = o[vt][4 * g4 + 3] * rs * gn.w * bfhi(gv.y);
      *(uint2*)(Os + t * 256 + v0 * 2) = make_uint2(pk2(o0, o1), pk2(o2, o3));
    }
  __syncthreads();
#pragma unroll
  for (int i = 0; i < 4; ++i) {
    const int idx = i * 256 + tid, row = idx >> 4, g16 = idx & 15;
    *(uint4*)(mix + (size_t)(c * 64 + row) * DM + 512 + h * 128 + g16 * 8) = *(const uint4*)(Os + idx * 16);
  }
  __syncthreads();
}

DI void gla_sample_item(const Params& p, int l, int item, char* lds) {
  const int tid = otid();
  const int b = item >> 2, h = item & 3;
  float* bS = (float*)lds;
  float* qtS = bS + 1024;
  float* ktS = qtS + 1024;
  float* keS = ktS + 1024;
  float* vS = keS + 1024;
  float* attS = vS + 2048;
  float* oS = attS + 256;
  const int row0 = TP + b * 16;
  const float* ab = (const float*)(p.ws + W_AB);
  const float* S0 = p.state_gla + ((size_t)(l * 32 + b) * 4 + h) * 8192;
  float s0v[64];
#pragma unroll
  for (int k = 0; k < 64; ++k) s0v[k] = S0[k * 128 + (tid & 127)];
  if (tid < 64) {
    const int k = tid;
    float wg[16];
#pragma unroll
    for (int j = 0; j < 16; ++j) wg[j] = p.w_gate_up[((size_t)l * 16 + j) * 256 + h * 64 + k];
    const float bias = p.b_gate[l * 256 + h * 64 + k];
    float cum = 0.f;
    for (int t = 0; t < 16; ++t) {
      const float* a = ab + (size_t)(row0 + t) * 16;
      float z = bias;
#pragma unroll
      for (int j = 0; j < 16; ++j) z += a[j] * wg[j];
      cum += logsigmoidf_(z) * (1.f / 16);
      bS[t * 64 + k] = cum;
    }
  }
  __syncthreads();
  const u16* qb = (const u16*)(p.ws + W_QB); const u16* kb = (const u16*)(p.ws + W_KB); const u16* vbs = (const u16*)(p.ws + W_VBS);
  for (int i = 0; i < 4; ++i) {
    const int idx = tid + 256 * i, t = idx >> 6, k = idx & 63;
    const float qv = bf2f(qb[(size_t)(row0 + t) * 256 + h * 64 + k]), kv = bf2f(kb[(size_t)(row0 + t) * 256 + h * 64 + k]);
    const float bb = bS[t * 64 + k], bl = bS[15 * 64 + k];
    qtS[idx] = qv * __expf(bb); ktS[idx] = kv * __expf(-bb); keS[idx] = kv * __expf(bl - bb);
  }
  for (int i = 0; i < 8; ++i) {
    const int idx = tid + 256 * i, t = idx >> 7, v = idx & 127;
    vS[idx] = bf2f(vbs[(size_t)(b * 16 + t) * 512 + h * 128 + v]);
  }
  __syncthreads();
  {
    const int t = tid >> 4, s = tid & 15;
    float a = 0.f;
    if (s <= t) for (int k = 0; k < 64; ++k) a += qtS[t * 64 + k] * ktS[s * 64 + k];
    attS[tid] = a;
  }
  __syncthreads();
  {
    const int v = tid & 127, tg = tid >> 7;
    float acc[8];
#pragma unroll
    for (int i = 0; i < 8; ++i) {
      const int t = tg * 8 + i; float a = 0.f;
      for (int s = 0; s < 16; ++s) a += attS[t * 16 + s] * vS[s * 128 + v];
      acc[i] = a;
    }
#pragma unroll
    for (int k = 0; k < 64; ++k) {
      const float s0 = s0v[k];
#pragma unroll
      for (int i = 0; i < 8; ++i) acc[i] += qtS[(tg * 8 + i) * 64 + k] * s0;
    }
#pragma unroll
    for (int i = 0; i < 8; ++i) oS[(tg * 8 + i) * 128 + v] = acc[i];
    float* So = p.out + O_SS + ((size_t)(l * 32 + b) * 4 + h) * 8192;
#pragma unroll
    for (int kk = 0; kk < 32; ++kk) {
      const int k = tg * 32 + kk;
      float a = __expf(bS[15 * 64 + k]) * (tg == 0 ? s0v[kk] : s0v[32 + kk]);
#pragma unroll
      for (int t = 0; t < 16; ++t) a += keS[t * 64 + k] * vS[t * 128 + v];
      So[k * 128 + v] = a;
    }
  }
  __syncthreads();
  {
    const int t = tid >> 4, pt = tid & 15;
    float ov[8]; float sq = 0.f;
#pragma unroll
    for (int j = 0; j < 8; ++j) { ov[j] = oS[t * 128 + pt * 8 + j]; sq += ov[j] * ov[j]; }
    sq += __shfl_xor(sq, 1); sq += __shfl_xor(sq, 2); sq += __shfl_xor(sq, 4); sq += __shfl_xor(sq, 8);
    const float rs = rsqrtf(sq * (1.f / 128) + 1e-6f);
    const size_t off = (size_t)(row0 + t) * DM + 512 + h * 128 + pt * 8;
    float gv[8]; unpk8(*(const uint4*)((const u16*)(p.ws + W_GATE) + off), gv);
    const float* gng = p.gla_norm_g + l * 128 + pt * 8;
#pragma unroll
    for (int j = 0; j < 8; ++j) ov[j] = ov[j] * rs * gng[j] * gv[j];
    *(uint4*)((u16*)(p.ws + W_MIX) + off) = pk8(ov);
  }
  __syncthreads();
}

DI void phaseS(const Params& p, int l, char* lds) {
  if (vgrid() == 512) {
    const int hb = vbid();
    if (hb < 128) { scan_item(p, l, hb); attn_prompt_item(p, l, hb, lds); attn_prompt_item(p, l, 128 + hb, lds); attn_prompt_item(p, l, 256 + hb, lds); }
    else if (hb < 256) { gla_sample_item(p, l, hb - 128, lds); attn_prompt_item(p, l, 384 + hb - 128, lds); }
    else { attn_sample_item(p, l, hb - 256, lds); attn_prompt_item(p, l, 512 + hb - 256, lds); attn_prompt_item(p, l, 768 + hb - 256, lds); }
    return;
  }
  for (int it = vbid(); it < 512 + 1024; it += vgrid()) {
    if (it < 128) scan_item(p, l, it);
    else if (it < 256) gla_sample_item(p, l, it - 128, lds);
    else if (it < 512) attn_sample_item(p, l, it - 256, lds);
    else attn_prompt_item(p, l, it - 512, lds);
  }
}

DI void phaseO(const Params& p, int l, char* lds) {
  for (int it = vbid(); it < NCH * 4; it += vgrid()) gla_out_prompt(p, l, it, lds);
  {
    const int tid = otid();
    const float* src = p.p_prompt + (size_t)l * TP * DPLE;
    u16* dst = (u16*)(p.ws + W_PB);
    const int per = (TP * DPLE / 8 + vgrid() * NTHR - 1) / (vgrid() * NTHR);
    for (int j = 0; j < per; ++j) {
      const size_t i = ((size_t)j * vgrid() + vbid()) * NTHR + tid;
      if (i < (size_t)TP * DPLE / 8) {
        const float4 f0 = *(const float4*)(src + i * 8), f1 = *(const float4*)(src + i * 8 + 4);
        *(uint4*)(dst + i * 8) = make_uint4(pk2(f0.x, f0.y), pk2(f0.z, f0.w), pk2(f1.x, f1.y), pk2(f1.z, f1.w));
      }
    }
  }
}

DI const float* hres_row(const Params& p, int l, int grow) {
  if (l == 0) return grow < TP ? p.x_prompt + (size_t)grow * DM : p.x_sample + (size_t)(grow - TP) * DM;
  return p.out + (size_t)grow * DM;
}
DI void phaseC(const Params& p, int l, char* lds, int vb) {
  const int tid = otid();
  float* C = (float*)lds;
  const u16* mix = (const u16*)(p.ws + W_MIX);
  const u16* wt = (const u16*)(p.ws + W_WOUT) + (size_t)l * DM * DM;
  u16* hb = (u16*)(p.ws + W_HB);
  const u16* wpe = (const u16*)(p.ws + W_WPE) + (size_t)l * DM * DPLE;
  u16* peb = (u16*)(p.ws + W_GATE);
  for (int rnd = 0;; ++rnd) {
    const int spos = seq_pos(rnd, vb);
    if (rnd * vgrid() >= MT * 16) break;
    if (spos >= MT * 16) continue;
    int mt, nn; pos_to_tile(spos, MT, 16, 4, mt, nn);
    nn = (nn + 8 * (rnd & 1)) & 15;
    const int tile = nn;
    const int nt = nn & 7, m0 = mt * 128, n0 = nt * 128;
    f32x16 acc[2][2];
    for (int i = 0; i < 2; ++i) for (int j = 0; j < 2; ++j) acc[i][j] = zero16();
    float ss[4] = {0.f, 0.f, 0.f, 0.f};
    if (tile & 8) {
      const float* pa = m0 < TP ? p.p_prompt + ((size_t)l * TP + m0) * DPLE : p.p_sample + ((size_t)l * TS + (m0 - TP)) * DPLE;
      gemm_main<true, false>(pa, DPLE, wpe + (size_t)n0 * DPLE, DPLE, DPLE, acc, lds, ss);
      acc_to_lds(acc, C);
      __syncthreads();
#pragma unroll 1
      for (int it = 0; it < 8; ++it) {
        const int item = it * 256 + tid, row = item >> 4, cgp = item & 15;
        const float4 a = *(const float4*)(C + row * 132 + cgp * 8), b = *(const float4*)(C + row * 132 + cgp * 8 + 4);
        const float v[8] = {a.x, a.y, a.z, a.w, b.x, b.y, b.z, b.w};
        *(uint4*)(peb + (size_t)(m0 + row) * DM + n0 + cgp * 8) = pk8(v);
      }
      __syncthreads();
      continue;
    }
    gemm_main<false, false>(mix + (size_t)m0 * DM, DM, wt + (size_t)n0 * DM, DM, DM, acc, lds, ss);
    acc_to_lds(acc, C);
    __syncthreads();
#pragma unroll 1
    for (int it = 0; it < 8; ++it) {
      const int item = it * 256 + tid, row = item >> 4, cgp = item & 15;
      const int grow = m0 + row;
      const float* hr = hres_row(p, l, grow) + n0 + cgp * 8;
      const float4 h0 = *(const float4*)hr, h1 = *(const float4*)(hr + 4);
      const float4 a = *(const float4*)(C + row * 132 + cgp * 8), b = *(const float4*)(C + row * 132 + cgp * 8 + 4);
      float v[8] = {h0.x + a.x, h0.y + a.y, h0.z + a.z, h0.w + a.w, h1.x + b.x, h1.y + b.y, h1.z + b.z, h1.w + b.w};
      float* d = p.out + (size_t)grow * DM + n0 + cgp * 8;
      *(float4*)d = make_float4(v[0], v[1], v[2], v[3]); *(float4*)(d + 4) = make_float4(v[4], v[5], v[6], v[7]);
      *(uint4*)(hb + (size_t)grow * DM + n0 + cgp * 8) = pk8(v);
      float sq = v[0] * v[0] + v[1] * v[1] + v[2] * v[2] + v[3] * v[3] + v[4] * v[4] + v[5] * v[5] + v[6] * v[6] + v[7] * v[7];
      sq += __shfl_xor(sq, 1); sq += __shfl_xor(sq, 2); sq += __shfl_xor(sq, 4); sq += __shfl_xor(sq, 8);
      if (cgp == 0) atomicAdd((float*)(p.ws + W_SSD) + grow, sq);
    }
    __syncthreads();
  }
}

DI void phaseD(const Params& p, int l, char* lds, int vb) {
  const int tid = otid();
  float* C = (float*)lds;
  float* rstd = (float*)(lds + 128 * 132 * 4);
  const u16* hb = (const u16*)(p.ws + W_HB);
  u16* hbn = (u16*)(p.ws + W_MIX);
  const u16* wpg = (const u16*)(p.ws + W_WPG) + (size_t)l * DM * DM;
  const u16* peb = (const u16*)(p.ws + W_GATE);
  for (int rnd = 0;; ++rnd) {
    const int spos = seq_pos(rnd, vb);
    if (rnd * vgrid() >= MT * 8) break;
    if (spos >= MT * 8) continue;
    int mt, nt; pos_to_tile(spos, MT, 8, 8, mt, nt);
    const int m0 = mt * 128, n0 = nt * 128;
    f32x16 acc[2][2];
    for (int i = 0; i < 2; ++i) for (int j = 0; j < 2; ++j) acc[i][j] = zero16();
    float ss[4] = {0.f, 0.f, 0.f, 0.f};
    gemm_main<false, false>(hb + (size_t)m0 * DM, DM, wpg + (size_t)n0 * DM, DM, DM, acc, lds, ss);
    acc_to_lds(acc, C);
    if (tid < 128) rstd[tid] = rsqrtf(((const float*)(p.ws + W_SSD))[m0 + tid] * (1.f / DM) + 1e-6f);
    __syncthreads();
#pragma unroll 1
    for (int it = 0; it < 8; ++it) {
      const int item = it * 256 + tid, row = item >> 4, cgp = item & 15;
      const int grow = m0 + row;
      const float rs = rstd[row];
      float* d = p.out + (size_t)grow * DM + n0 + cgp * 8;
      const float4 h0 = *(const float4*)d, h1 = *(const float4*)(d + 4);
      float pv[8]; unpk8(*(const uint4*)(peb + (size_t)grow * DM + n0 + cgp * 8), pv);
      const float4 a = *(const float4*)(C + row * 132 + cgp * 8), b = *(const float4*)(C + row * 132 + cgp * 8 + 4);
      float v[8] = {h0.x + sigmoidf_(a.x * rs) * pv[0], h0.y + sigmoidf_(a.y * rs) * pv[1], h0.z + sigmoidf_(a.z * rs) * pv[2], h0.w + sigmoidf_(a.w * rs) * pv[3],
                    h1.x + sigmoidf_(b.x * rs) * pv[4], h1.y + sigmoidf_(b.y * rs) * pv[5], h1.z + sigmoidf_(b.z * rs) * pv[6], h1.w + sigmoidf_(b.w * rs) * pv[7]};
      *(float4*)d = make_float4(v[0], v[1], v[2], v[3]); *(float4*)(d + 4) = make_float4(v[4], v[5], v[6], v[7]);
      *(uint4*)(hbn + (size_t)grow * DM + n0 + cgp * 8) = pk8(v);
      float sq = v[0] * v[0] + v[1] * v[1] + v[2] * v[2] + v[3] * v[3] + v[4] * v[4] + v[5] * v[5] + v[6] * v[6] + v[7] * v[7];
      sq += __shfl_xor(sq, 1); sq += __shfl_xor(sq, 2); sq += __shfl_xor(sq, 4); sq += __shfl_xor(sq, 8);
      if (cgp == 0) atomicAdd((float*)(p.ws + W_SSA) + grow, sq);
    }
    __syncthreads();
  }
}

struct EpiC {
  const float* hres; float* out; u16* hb; float* ss;
  DI void operator()(const pg8::f32x4 (&acc)[2][2][4][2], const pg8::Unit& u, int wr, int wc, int fr, int fq) const {
    const int cb = u.pn * 256 + wc * 64 + 8 * fq;
#pragma unroll
    for (int ai = 0; ai < 2; ++ai)
#pragma unroll
      for (int m = 0; m < 4; ++m) {
        const int row = u.pm * 256 + ai * 128 + wr * 64 + m * 16 + fr;
        float sq = 0.f;
#pragma unroll
        for (int bj = 0; bj < 2; ++bj) {
          const size_t o = (size_t)row * DM + cb + 32 * bj;
          const float4 h0 = *(const float4*)(hres + o), h1 = *(const float4*)(hres + o + 4);
          float v[8] = {h0.x + acc[ai][bj][m][0][0], h0.y + acc[ai][bj][m][0][1], h0.z + acc[ai][bj][m][0][2], h0.w + acc[ai][bj][m][0][3],
                        h1.x + acc[ai][bj][m][1][0], h1.y + acc[ai][bj][m][1][1], h1.z + acc[ai][bj][m][1][2], h1.w + acc[ai][bj][m][1][3]};
          *(float4*)(out + o) = make_float4(v[0], v[1], v[2], v[3]); *(float4*)(out + o + 4) = make_float4(v[4], v[5], v[6], v[7]);
          *(uint4*)(hb + o) = pk8(v);
#pragma unroll
          for (int e = 0; e < 8; ++e) sq += v[e] * v[e];
        }
        sq += __shfl_xor(sq, 16); sq += __shfl_xor(sq, 32);
        if (fq == 0) atomicAdd(ss + row, sq);
        if (m & 1) asm volatile("" ::: "memory");
      }
  }
};
struct EpiPe {
  u16* peb;
  DI void operator()(const pg8::f32x4 (&acc)[2][2][4][2], const pg8::Unit& u, int wr, int wc, int fr, int fq) const {
    const int cb = u.pn * 256 + wc * 64 + 8 * fq;
#pragma unroll
    for (int ai = 0; ai < 2; ++ai)
#pragma unroll
      for (int m = 0; m < 4; ++m) {
        const int row = u.pm * 256 + ai * 128 + wr * 64 + m * 16 + fr;
#pragma unroll
        for (int bj = 0; bj < 2; ++bj) {
          const float v[8] = {acc[ai][bj][m][0][0], acc[ai][bj][m][0][1], acc[ai][bj][m][0][2], acc[ai][bj][m][0][3], acc[ai][bj][m][1][0], acc[ai][bj][m][1][1], acc[ai][bj][m][1][2], acc[ai][bj][m][1][3]};
          *(uint4*)(peb + (size_t)row * DM + cb + 32 * bj) = pk8(v);
        }
      }
  }
};
struct EpiD {
  float* out; const u16* peb; u16* hbn; const float* ssd; float* ssa;
  DI void operator()(const pg8::f32x4 (&acc)[2][2][4][2], const pg8::Unit& u, int wr, int wc, int fr, int fq) const {
    const int cb = u.pn * 256 + wc * 64 + 8 * fq;
    float rsv[8];
#pragma unroll
    for (int i = 0; i < 8; ++i) rsv[i] = ssd[u.pm * 256 + (i >> 2) * 128 + wr * 64 + (i & 3) * 16 + fr];
#pragma unroll
    for (int i = 0; i < 8; ++i) rsv[i] = rsqrtf(rsv[i] * (1.f / DM) + 1e-6f);
#pragma unroll
    for (int ai = 0; ai < 2; ++ai)
#pragma unroll
      for (int m = 0; m < 4; ++m) {
        const int row = u.pm * 256 + ai * 128 + wr * 64 + m * 16 + fr;
        const float rs = rsv[ai * 4 + m];
        float sq = 0.f;
#pragma unroll
        for (int bj = 0; bj < 2; ++bj) {
          const size_t o = (size_t)row * DM + cb + 32 * bj;
          const float4 h0 = *(const float4*)(out + o), h1 = *(const float4*)(out + o + 4);
          float pv[8]; unpk8(*(const uint4*)(peb + o), pv);
          float v[8] = {h0.x + sigmoidf_(acc[ai][bj][m][0][0] * rs) * pv[0], h0.y + sigmoidf_(acc[ai][bj][m][0][1] * rs) * pv[1], h0.z + sigmoidf_(acc[ai][bj][m][0][2] * rs) * pv[2], h0.w + sigmoidf_(acc[ai][bj][m][0][3] * rs) * pv[3],
                        h1.x + sigmoidf_(acc[ai][bj][m][1][0] * rs) * pv[4], h1.y + sigmoidf_(acc[ai][bj][m][1][1] * rs) * pv[5], h1.z + sigmoidf_(acc[ai][bj][m][1][2] * rs) * pv[6], h1.w + sigmoidf_(acc[ai][bj][m][1][3] * rs) * pv[7]};
          *(float4*)(out + o) = make_float4(v[0], v[1], v[2], v[3]); *(float4*)(out + o + 4) = make_float4(v[4], v[5], v[6], v[7]);
          *(uint4*)(hbn + o) = pk8(v);
#pragma unroll
          for (int e = 0; e < 8; ++e) sq += v[e] * v[e];
        }
        sq += __shfl_xor(sq, 16); sq += __shfl_xor(sq, 32);
        if (fq == 0) atomicAdd(ssa + row, sq);
        if (m & 1) asm volatile("" ::: "memory");
      }
  }
};

template <bool AF32, int K>
DI void mini_gemm(const void* __restrict__ A, int lda, const u16* __restrict__ Bt, int ldb, int r0, int c0, float* red, float (&o)[4]) {
  const int tid = otid(), lane = tid & 63, w = tid >> 6, r = lane & 31, hh = lane >> 5;
  char* As = (char*)red;
  constexpr int KH = K < 512 ? K : 512;
  constexpr int CPR = KH >> 3;
  constexpr int NP = 32 * CPR / 256;
  char* Bs = As + 32 * KH * 2;
  f32x16 acc = zero16();
  for (int kh = 0; kh < K; kh += KH) {
    uint4 ar[NP], br[NP];
#pragma unroll
    for (int i = 0; i < NP; ++i) {
      const int idx = i * 256 + tid;
      {
        const int row = idx / CPR, ch = idx - row * CPR;
        if (AF32) {
          const float* ap = (const float*)A + (size_t)(r0 + row) * lda + kh + ch * 8;
          const float4 f0 = *(const float4*)ap, f1 = *(const float4*)(ap + 4);
          ar[i] = make_uint4(pk2(f0.x, f0.y), pk2(f0.z, f0.w), pk2(f1.x, f1.y), pk2(f1.z, f1.w));
        } else {
          ar[i] = *(const uint4*)((const u16*)A + (size_t)(r0 + row) * lda + kh + ch * 8);
        }
        br[i] = *(const uint4*)(Bt + (size_t)(c0 + row) * ldb + kh + ch * 8);
      }
    }
#pragma unroll
    for (int i = 0; i < NP; ++i) {
      const int idx = i * 256 + tid;
      {
        const int row = idx / CPR, ch = idx - row * CPR;
        const int off = row * KH * 2 + (((ch & ~15) | ((ch ^ row) & 15)) << 4);
        *(uint4*)(As + off) = ar[i]; *(uint4*)(Bs + off) = br[i];
      }
    }
    __syncthreads();
    const int cw = w * (CPR >> 2);
#pragma unroll
    for (int ks = 0; ks < (KH >> 6); ++ks) {
      const int ch = cw + 2 * ks + hh;
      const int off = r * KH * 2 + (((ch & ~15) | ((ch ^ r) & 15)) << 4);
      acc = MFMA(*(const bf16x8*)(As + off), *(const bf16x8*)(Bs + off), acc);
    }
    __syncthreads();
  }
#pragma unroll
  for (int g = 0; g < 16; ++g) red[w * 1056 + crow(g, hh) * 33 + r] = acc[g];
  __syncthreads();
  const int pr = tid >> 3, pc = (tid & 7) * 4;
#pragma unroll
  for (int i = 0; i < 4; ++i) o[i] = red[pr * 33 + pc + i] + red[1056 + pr * 33 + pc + i] + red[2112 + pr * 33 + pc + i] + red[3168 + pr * 33 + pc + i];
  __syncthreads();
}

DI void phaseC8(const Params& p, int l, char* lds_all, char* lds) {
  const u16* mix = (const u16*)(p.ws + W_MIX);
  const u16* wout = (const u16*)(p.ws + W_WOUT) + (size_t)l * DM * DM;
  const u16* wpe = (const u16*)(p.ws + W_WPE) + (size_t)l * DM * DPLE;
  u16* hb = (u16*)(p.ws + W_HB);
  u16* peb = (u16*)(p.ws + W_GATE);
  float* ssD = (float*)(p.ws + W_SSD);
  {
    pg8::Gemm g{mix, wout, TP, DM, DM};
    pg8::StaticOrder S; S.init(TP, DM, (int)gridDim.x, obid());
    EpiC E{l == 0 ? p.x_prompt : p.out, p.out, hb, ssD};
    pg8::gemm_phase<EpiC>((LAS unsigned char*)lds_all, g, S, E);
  }
  {
    pg8::Gemm g{(const u16*)(p.ws + W_PB), wpe, TP, DM, DPLE};
    pg8::StaticOrder S; S.init(TP, DM, (int)gridDim.x, obid());
    EpiPe E{peb};
    pg8::gemm_phase<EpiPe>((LAS unsigned char*)lds_all, g, S, E);
  }
  const int tid = otid();
  for (int mt = vbid(); mt < 512; mt += vgrid()) {
    const int r0 = TP + (mt >> 5) * 32, c0 = (mt & 31) * 32;
    const int row = r0 + (tid >> 3), col = c0 + (tid & 7) * 4;
    float o[4];
    mini_gemm<false, DM>(mix, DM, wout, DM, r0, c0, (float*)lds, o);
    {
      const size_t off = (size_t)row * DM + col;
      const float4 h = *(const float4*)(l == 0 ? p.x_sample + (size_t)(row - TP) * DM + col : p.out + off);
      const float v0 = h.x + o[0], v1 = h.y + o[1], v2 = h.z + o[2], v3 = h.w + o[3];
      *(float4*)(p.out + off) = make_float4(v0, v1, v2, v3);
      *(uint2*)(hb + off) = make_uint2(pk2(v0, v1), pk2(v2, v3));
      float sq = v0 * v0 + v1 * v1 + v2 * v2 + v3 * v3;
      sq += __shfl_xor(sq, 1); sq += __shfl_xor(sq, 2); sq += __shfl_xor(sq, 4);
      if ((tid & 7) == 0) atomicAdd(ssD + row, sq);
    }
    mini_gemm<true, DPLE>(p.p_sample + (size_t)l * TS * DPLE, DPLE, wpe, DPLE, r0 - TP, c0, (float*)lds, o);
    *(uint2*)(peb + (size_t)row * DM + col) = make_uint2(pk2(o[0], o[1]), pk2(o[2], o[3]));
  }
}

DI void phaseD8(const Params& p, int l, char* lds_all, char* lds) {
  const u16* hb = (const u16*)(p.ws + W_HB);
  const u16* wpg = (const u16*)(p.ws + W_WPG) + (size_t)l * DM * DM;
  const u16* peb = (const u16*)(p.ws + W_GATE);
  u16* hbn = (u16*)(p.ws + W_MIX);
  const float* ssD = (const float*)(p.ws + W_SSD);
  float* ssA = (float*)(p.ws + W_SSA);
  {
    pg8::Gemm g{hb, wpg, TP, DM, DM};
    pg8::StaticOrder S; S.init(TP, DM, (int)gridDim.x, obid());
    EpiD E{p.out, peb, hbn, ssD, ssA};
    pg8::gemm_phase<EpiD>((LAS unsigned char*)lds_all, g, S, E);
  }
  const int tid = otid();
  for (int mt = vbid(); mt < 512; mt += vgrid()) {
    const int r0 = TP + (mt >> 5) * 32, c0 = (mt & 31) * 32;
    const int row = r0 + (tid >> 3), col = c0 + (tid & 7) * 4;
    float o[4];
    mini_gemm<false, DM>(hb, DM, wpg, DM, r0, c0, (float*)lds, o);
    const size_t off = (size_t)row * DM + col;
    const float rs = rsqrtf(ssD[row] * (1.f / DM) + 1e-6f);
    const float4 h = *(const float4*)(p.out + off);
    const uint2 pe = *(const uint2*)(peb + off);
    const float v0 = h.x + sigmoidf_(o[0] * rs) * bflo(pe.x), v1 = h.y + sigmoidf_(o[1] * rs) * bfhi(pe.x), v2 = h.z + sigmoidf_(o[2] * rs) * bflo(pe.y), v3 = h.w + sigmoidf_(o[3] * rs) * bfhi(pe.y);
    *(float4*)(p.out + off) = make_float4(v0, v1, v2, v3);
    *(uint2*)(hbn + off) = make_uint2(pk2(v0, v1), pk2(v2, v3));
    float sq = v0 * v0 + v1 * v1 + v2 * v2 + v3 * v3;
    sq += __shfl_xor(sq, 1); sq += __shfl_xor(sq, 2); sq += __shfl_xor(sq, 4);
    if ((tid & 7) == 0) atomicAdd(ssA + row, sq);
  }
}

__global__ void __launch_bounds__(NBLK_THREADS, 2) hymba_fwd(Params p) {
  extern __shared__ __attribute__((aligned(16))) char lds_all[];
  cg::grid_group grid = cg::this_grid();
  char* lds = lds_all + hhalf() * LDS_HALF;
  if (threadIdx.x == 0) *(uint4*)(lds_all + LDS_MAIN) = make_uint4(0u, 0u, 0u, 0u);
  __syncthreads();
  XcdBarrier bar = xcd_barrier_post((unsigned*)(p.ws + W_BAR), (volatile LAS unsigned*)(lds_all + LDS_MAIN));
  phase0(p, lds);
  grid.sync();
  for (int l = 0; l < DEPTH; ++l) {
    phaseA8(p, l, lds_all);
    xcd_barrier(bar);
    phaseB(p, l, lds);
    xcd_barrier(bar);
    phaseS(p, l, lds);
    xcd_barrier(bar);
    phaseO(p, l, lds);
    xcd_barrier(bar);
    phaseC8(p, l, lds_all, lds);
    xcd_barrier(bar);
    phaseD8(p, l, lds_all, lds);
    if (l + 1 < DEPTH) xcd_barrier(bar);
  }
}

extern "C" void kernel_launch(void* const* d_in, const int* in_sizes, int n_in, void* d_out, int out_size, void* d_ws, size_t ws_size, hipStream_t stream) {
  static int grid_blocks = 0;
  if (!grid_blocks) {
    int dev = 0, cus = 0, per_cu = 0;
    (void)hipGetDevice(&dev);
    (void)hipDeviceGetAttribute(&cus, hipDeviceAttributeMultiprocessorCount, dev);
    if (hipFuncSetAttribute((const void*)hymba_fwd, hipFuncAttributeMaxDynamicSharedMemorySize, LDS_BYTES) != hipSuccess) fprintf(stderr, "kernel_launch: hipFuncSetAttribute(%d B dynamic LDS) failed\n", LDS_BYTES);
    (void)hipOccupancyMaxActiveBlocksPerMultiprocessor(&per_cu, hymba_fwd, NBLK_THREADS, LDS_BYTES);
    if (per_cu > 1) per_cu = 1;
    if (per_cu < 1) { fprintf(stderr, "kernel_launch: occupancy query reports %d blocks per CU\n", per_cu); per_cu = 1; }
    grid_blocks = cus * per_cu;
    if (ws_size < W_END) fprintf(stderr, "kernel_launch: workspace too small: %zu < %zu\n", ws_size, (size_t)W_END);
  }
  Params p{};
  const float** f = (const float**)&p;
  for (int i = 0; i < 19; ++i) f[i] = (const float*)d_in[i];
  p.out = (float*)d_out;
  p.ws = (char*)d_ws;
  (void)hipMemsetAsync((char*)d_ws + W_BAR, 0, XCD_BAR_WORDS * 4, stream);
  void* args[] = {&p};
  hipError_t e = hipLaunchCooperativeKernel((void*)hymba_fwd, dim3(grid_blocks), dim3(NBLK_THREADS), args, LDS_BYTES, stream);
  if (e != hipSuccess) fprintf(stderr, "cooperative launch failed: %s (grid %d)\n", hipGetErrorString(e), grid_blocks);
}
```

```cpp
#include <hip/hip_runtime.h>
#include <hip/hip_cooperative_groups.h>
#include <cstdio>
namespace cg = cooperative_groups;

#define DI __device__ __forceinline__
typedef __attribute__((ext_vector_type(8))) short bf16x8;
typedef __attribute__((ext_vector_type(16))) float f32x16;
typedef __attribute__((ext_vector_type(2))) __bf16 bf2_t;
typedef unsigned short u16;

constexpr int TP = 16384, TS = 512, TT = TP + TS;
constexpr int DM = 1024, DEPTH = 4, DPLE = 256;
constexpr int NIN = 2832, NINP = 2944;
constexpr int NTHR = 256;
constexpr int MT = TT / 128;
constexpr int NCH = TP / 64;
constexpr int TPS = TP + 192;
constexpr int XCD_BAR_WORDS_C = 4032;

constexpr size_t O_Y = 0;
constexpr size_t O_KP = (size_t)TT * DM;
constexpr size_t O_VP = O_KP + 4 * 16384;
constexpr size_t O_SP = O_VP + 4 * 16384;
constexpr size_t O_KS = O_SP + 4 * 32768;
constexpr size_t O_VS = O_KS + 4 * 65536;
constexpr size_t O_SS = O_VS + 4 * 65536;

constexpr size_t W_WIN = 0;
constexpr size_t W_WOUT = W_WIN + (size_t)DEPTH * NINP * DM * 2;
constexpr size_t W_WPG = W_WOUT + (size_t)DEPTH * DM * DM * 2;
constexpr size_t W_WPE = W_WPG + (size_t)DEPTH * DM * DM * 2;
constexpr size_t W_HB = W_WPE + (size_t)DEPTH * DM * DPLE * 2;
constexpr size_t W_Q = W_HB + (size_t)TT * DM * 2;
constexpr size_t W_K = W_Q + (size_t)TT * 512 * 2;
constexpr size_t W_VT = W_K + (size_t)TT * 128 * 2;
constexpr size_t W_GATE = W_VT + (size_t)128 * TPS * 2;
constexpr size_t W_QB = W_GATE + (size_t)TT * DM * 2;
constexpr size_t W_KB = W_QB + (size_t)TT * 256 * 2;
constexpr size_t W_KBT = W_KB + (size_t)TT * 256 * 2;
constexpr size_t W_VBS = W_KBT + (size_t)256 * TPS * 2;
constexpr size_t W_VBT = W_VBS + (size_t)TS * 512 * 2;
constexpr size_t W_AB = W_VBT + (size_t)512 * TPS * 2;
constexpr size_t W_MIX = W_AB + (size_t)TT * 16 * 4;
constexpr size_t W_S = W_MIX + (size_t)TT * DM * 2;
constexpr size_t W_DEC = W_S + (size_t)NCH * 32768 * 4;
constexpr size_t W_ROPE = W_DEC + (size_t)NCH * 256 * 4;
constexpr size_t W_SSA = W_ROPE + (size_t)TP * 16 * 4;
constexpr size_t W_SSD = W_SSA + (size_t)TT * 4;
constexpr size_t W_PB = W_SSD + (size_t)TT * 4;
constexpr size_t W_BAR = W_PB + (size_t)TP * DPLE * 2;
constexpr size_t W_END = W_BAR + XCD_BAR_WORDS_C * 4;

constexpr int LDS_HALF = 128 * 132 * 4 + 512;
constexpr int LDS_MAIN = 2 * LDS_HALF;
constexpr int LDS_BYTES = LDS_MAIN + 16;
constexpr int NBLK_THREADS = 512;

struct Params {
  const float *x_prompt, *x_sample, *cache_k, *cache_v, *state_gla, *p_prompt, *p_sample, *norm_g, *w_in, *q_norm_g, *k_norm_g,
      *sinks, *w_gate_up, *b_gate, *gla_norm_g, *w_out, *pe_norm_g, *w_pe, *w_pg;
  float* out;
  char* ws;
};

DI unsigned pk2(float a, float b) { bf2_t v; v[0] = (__bf16)a; v[1] = (__bf16)b; return __builtin_bit_cast(unsigned, v); }
DI float bflo(unsigned u) { return __uint_as_float(u << 16); }
DI float bfhi(unsigned u) { return __uint_as_float(u & 0xffff0000u); }
DI float bf2f(u16 u) { return __uint_as_float(((unsigned)u) << 16); }
DI uint4 pk8(const float* v) { return make_uint4(pk2(v[0], v[1]), pk2(v[2], v[3]), pk2(v[4], v[5]), pk2(v[6], v[7])); }
DI void unpk8(uint4 u, float* v) {
  v[0] = bflo(u.x); v[1] = bfhi(u.x); v[2] = bflo(u.y); v[3] = bfhi(u.y);
  v[4] = bflo(u.z); v[5] = bfhi(u.z); v[6] = bflo(u.w); v[7] = bfhi(u.w);
}
DI int otid() { int t = threadIdx.x & 255; asm volatile("" : "+v"(t)); return t; }
DI int hhalf() { return __builtin_amdgcn_readfirstlane((int)(threadIdx.x >> 8)); }
DI int vbid() { return (int)blockIdx.x * 2 + hhalf(); }
DI int obid() { int b = blockIdx.x; asm volatile("" : "+s"(b)); return b; }
DI int vgrid() { return (int)gridDim.x * 2; }
DI size_t tidx(int NR, int col, int token) { return ((size_t)(token >> 6) * NR + col) * 64 + (token & 63); }
DI int crow(int reg, int h) { return (reg & 3) + 8 * (reg >> 2) + 4 * h; }
#define MFMA(a, b, c) __builtin_amdgcn_mfma_f32_32x32x16_bf16((a), (b), (c), 0, 0, 0)
DI bf16x8 as_frag(uint4 u) { return __builtin_bit_cast(bf16x8, u); }
DI f32x16 zero16() { f32x16 z; for (int i = 0; i < 16; ++i) z[i] = 0.f; return z; }
DI float sigmoidf_(float x) { return __builtin_amdgcn_rcpf(1.f + __expf(-x)); }
DI float siluf_(float x) { return x * __builtin_amdgcn_rcpf(1.f + __expf(-x)); }
DI float logsigmoidf_(float z) { return fminf(z, 0.f) - __logf(1.f + __expf(-fabsf(z))); }


#define XB_TMO      128
#define XB_XCNT(j)  (256  + 64 * (j))
#define XB_XSUB(j)  (1280 + 64 * (j))
#define XB_XGEN(j)  (2304 + 64 * (j))
#define XB_TOP      3328
#define XB_TOPGEN   3392
#define XB_RANK(j)  (3456 + 64 * (j))
#define XCD_BAR_WORDS 4032
#define XB_SPIN_CAP (1u << 22)
#define LAS __attribute__((address_space(3)))
DI unsigned xb_ld(unsigned* p) { return __hip_atomic_load(p, __ATOMIC_RELAXED, __HIP_MEMORY_SCOPE_AGENT); }
DI unsigned xb_add(unsigned* p, unsigned v) { return __hip_atomic_fetch_add(p, v, __ATOMIC_RELAXED, __HIP_MEMORY_SCOPE_AGENT); }
DI unsigned xb_xcc_id() { return (unsigned)__builtin_amdgcn_s_getreg((3 << 11) | 20) & 0xFu; }
#define XB_SPIN(cond, bar) do { unsigned _sp = 0; while (cond) { __builtin_amdgcn_s_sleep(1); \
    if ((++_sp & 255u) == 0u) { if (xb_ld(&(bar)[XB_TMO])) break; if (_sp > XB_SPIN_CAP) { atomicAdd(&(bar)[XB_TMO], 1u); break; } } } } while (0)
struct XcdBarrier { unsigned* bar; unsigned x; volatile LAS unsigned* st; };
DI XcdBarrier xcd_barrier_post(unsigned* bar, volatile LAS unsigned* st) {
  XcdBarrier b; b.bar = bar; b.x = xb_xcc_id(); b.st = st;
  if (threadIdx.x == 0) (void)xb_add(&bar[XB_XCNT(b.x)], 1u);
  return b;
}
DI void xcd_barrier_complete(unsigned* bar, unsigned x, unsigned& nloc, unsigned& nx) {
  const unsigned G = gridDim.x * gridDim.y * gridDim.z;
  unsigned sum, cnt, mine, sp = 0u;
  for (;;) {
    sum = 0u; cnt = 0u; mine = 0u;
#pragma unroll
    for (unsigned j = 0; j < 16; ++j) { const unsigned c = xb_ld(&bar[XB_XCNT(j)]); sum += c; cnt += (c > 0u) ? 1u : 0u; mine = (j == x) ? c : mine; }
    if (sum == G) break;
    __builtin_amdgcn_s_sleep(1);
    if ((++sp & 255u) == 0u) { if (xb_ld(&bar[XB_TMO])) break; if (sp > XB_SPIN_CAP) { atomicAdd(&bar[XB_TMO], 1u); break; } }
  }
  nloc = mine > 0u ? mine : 1u; nx = cnt > 0u ? cnt : 1u;
}
DI void xcd_barrier(const XcdBarrier& b) {
  asm volatile("s_waitcnt vmcnt(0)" ::: "memory");
  __syncthreads();
  if (threadIdx.x == 0) {
    unsigned* bar = b.bar;
    __builtin_amdgcn_s_waitcnt(0);
    unsigned nloc = b.st[0], nx = b.st[1];
    if (nloc == 0u) { xcd_barrier_complete(bar, b.x, nloc, nx); b.st[0] = nloc; b.st[1] = nx; }
    const unsigned old = xb_add(&bar[XB_XSUB(b.x)], 1u);
    const unsigned gen = old / nloc;
    if (old + 1u == (gen + 1u) * nloc) {
      __builtin_amdgcn_fence(__ATOMIC_RELEASE, "agent");
      asm volatile("s_waitcnt vmcnt(0)" ::: "memory");
      const unsigned og = xb_add(&bar[XB_TOP], 1u);
      const unsigned tg = og / nx;
      if (og + 1u == (tg + 1u) * nx) xb_add(&bar[XB_TOPGEN], 1u);
      else XB_SPIN(xb_ld(&bar[XB_TOPGEN]) == tg, bar);
      __builtin_amdgcn_fence(__ATOMIC_ACQUIRE, "agent");
      xb_add(&bar[XB_XGEN(b.x)], 1u);
      asm volatile("s_waitcnt vmcnt(0)" ::: "memory");
    } else {
      XB_SPIN(xb_ld(&bar[XB_XGEN(b.x)]) == gen, bar);
      __builtin_amdgcn_fence(__ATOMIC_ACQUIRE, "agent");
      asm volatile("s_waitcnt vmcnt(0)" ::: "memory");
    }
  }
  __syncthreads();
}

struct GStage { uint4 a0, a1, a2, a3, b0, b1, b2, b3; };
template <bool AF32>
DI uint4 gl_a(const void* __restrict__ Ab, size_t off) {
  if (AF32) {
    const float* ap = (const float*)Ab + off;
    const float4 f0 = *(const float4*)ap, f1 = *(const float4*)(ap + 4);
    return make_uint4(pk2(f0.x, f0.y), pk2(f0.z, f0.w), pk2(f1.x, f1.y), pk2(f1.z, f1.w));
  }
  return *(const uint4*)((const u16*)Ab + off);
}
template <bool AF32>
DI void g_load(GStage& s, const void* __restrict__ Ab, int lda, const u16* __restrict__ Bb, int ldb, int kt, int sr, int sc) {
  const size_t ao = (size_t)sr * lda + kt * 64 + sc * 8, bo = (size_t)sr * ldb + kt * 64 + sc * 8;
  s.a0 = gl_a<AF32>(Ab, ao); s.a1 = gl_a<AF32>(Ab, ao + (size_t)32 * lda); s.a2 = gl_a<AF32>(Ab, ao + (size_t)64 * lda); s.a3 = gl_a<AF32>(Ab, ao + (size_t)96 * lda);
  s.b0 = *(const uint4*)(Bb + bo); s.b1 = *(const uint4*)(Bb + bo + (size_t)32 * ldb); s.b2 = *(const uint4*)(Bb + bo + (size_t)64 * ldb); s.b3 = *(const uint4*)(Bb + bo + (size_t)96 * ldb);
}
DI float sq8(uint4 u) { float v[8]; unpk8(u, v); float s = 0.f;
#pragma unroll
  for (int j = 0; j < 8; ++j) s += v[j] * v[j];
  return s; }
DI void l_store(const GStage& s, char* base, int sr, int sc) {
  char* a = base; char* b = base + 16384;
  const int sw = ((sc ^ ((sr >> 1) & 7)) << 4);
  const int o0 = sr * 128 + sw;
  *(uint4*)(a + o0) = s.a0; *(uint4*)(a + o0 + 4096) = s.a1; *(uint4*)(a + o0 + 8192) = s.a2; *(uint4*)(a + o0 + 12288) = s.a3;
  *(uint4*)(b + o0) = s.b0; *(uint4*)(b + o0 + 4096) = s.b1; *(uint4*)(b + o0 + 8192) = s.b2; *(uint4*)(b + o0 + 12288) = s.b3;
}
DI float sq8f(bf16x8 f) { const uint4 u = __builtin_bit_cast(uint4, f); return sq8(u); }
template <bool SUMSQ>
DI void mma_step(const char* a, f32x16 (&acc)[2][2], int wm, int wn, int r, int hh, float (&ss)[4]) {
  const char* b = a + 16384;
#pragma unroll
  for (int ks = 0; ks < 4; ++ks) {
    bf16x8 af[2], bfr[2];
#pragma unroll
    for (int i = 0; i < 2; ++i) {
      const int arow = wm * 64 + i * 32 + r;
      af[i] = *(const bf16x8*)(a + arow * 128 + (((2 * ks + hh) ^ ((arow >> 1) & 7)) << 4));
      const int brow = wn * 64 + i * 32 + r;
      bfr[i] = *(const bf16x8*)(b + brow * 128 + (((2 * ks + hh) ^ ((brow >> 1) & 7)) << 4));
    }
#pragma unroll
    for (int mi = 0; mi < 2; ++mi)
#pragma unroll
      for (int ni = 0; ni < 2; ++ni) acc[mi][ni] = MFMA(af[mi], bfr[ni], acc[mi][ni]);
    if (SUMSQ) { ss[0] += sq8f(af[0]); ss[1] += sq8f(af[1]); }
  }
}
template <bool AF32, bool SUMSQ>
DI void gemm_main(const void* __restrict__ Ab, int lda, const u16* __restrict__ Bb, int ldb, int K, f32x16 (&acc)[2][2], char* lds, float (&ss)[4]) {
  const int tid = otid(), lane = tid & 63, w = tid >> 6;
  const int wm = w >> 1, wn = w & 1, r = lane & 31, hh = lane >> 5;
  const int sc = tid & 7, sr = tid >> 3;
  GStage s0, s1;
  const int nk = K >> 6;
  g_load<AF32>(s0, Ab, lda, Bb, ldb, 0, sr, sc);
  g_load<AF32>(s1, Ab, lda, Bb, ldb, 1, sr, sc);
  l_store(s0, lds, sr, sc);
  __syncthreads();
  for (int kt = 0; kt < nk; kt += 2) {
    if (kt + 2 < nk) g_load<AF32>(s0, Ab, lda, Bb, ldb, kt + 2, sr, sc);
    __builtin_amdgcn_sched_barrier(0);
    mma_step<SUMSQ>(lds, acc, wm, wn, r, hh, ss);
    __builtin_amdgcn_sched_barrier(0);
    l_store(s1, lds + 32768, sr, sc);
    __syncthreads();
    if (kt + 3 < nk) g_load<AF32>(s1, Ab, lda, Bb, ldb, kt + 3, sr, sc);
    __builtin_amdgcn_sched_barrier(0);
    mma_step<SUMSQ>(lds + 32768, acc, wm, wn, r, hh, ss);
    __builtin_amdgcn_sched_barrier(0);
    if (kt + 2 < nk) l_store(s0, lds, sr, sc);
    __syncthreads();
  }
}

DI void acc_to_lds(const f32x16 (&acc)[2][2], float* C) {
  const int tid = otid(), lane = tid & 63, w = tid >> 6;
  const int wm = w >> 1, wn = w & 1, r = lane & 31, hh = lane >> 5;
#pragma unroll
  for (int mi = 0; mi < 2; ++mi)
#pragma unroll
    for (int ni = 0; ni < 2; ++ni)
#pragma unroll
      for (int g = 0; g < 16; ++g) C[(wm * 64 + mi * 32 + crow(g, hh)) * 132 + wn * 64 + ni * 32 + r] = acc[mi][ni][g];
}
DI void ss_to_rstd(const float (&ss)[4], float* rstd, float invK) {
  const int tid = otid(), lane = tid & 63, w = tid >> 6;
  const int wm = w >> 1, wn = w & 1, r = lane & 31, hh = lane >> 5;
#pragma unroll
  for (int i = 0; i < 2; ++i) {
    float s = ss[i];
    s += __shfl_xor(s, 32);
    if (wn == 0 && hh == 0) rstd[wm * 64 + i * 32 + r] = rsqrtf(s * invK + 1e-6f);
  }
}

DI int seq_pos(int round, int vb) {
  const int G = vgrid();
  if (G != 512) return round * G + vbid();
  return (round * 8 + (vb >> 6)) * 64 + (vb & 63);
}
DI void pos_to_tile(int s, int MTn, int NTn, int SH, int& mt, int& nt) {
  const int strip_sz = SH * NTn;
  const int strip = s / strip_sz; const int w = s - strip * strip_sz;
  const int hgt = min(SH, MTn - strip * SH);
  nt = w / hgt; mt = strip * SH + (w - nt * hgt);
}

DI void transpose_item(const float* __restrict__ src, int K, int N, const float* __restrict__ g, u16* __restrict__ dst, int k0, int n0, float* L) {
  const int tid = otid();
#pragma unroll
  for (int i = 0; i < 4; ++i) {
    const int kk = i * 16 + (tid >> 4), n4 = (tid & 15) * 4;
    float4 v = make_float4(0.f, 0.f, 0.f, 0.f);
    if (n0 + n4 < N) {
      v = *(const float4*)(src + (size_t)(k0 + kk) * N + n0 + n4);
      if (g) { const float gg = g[k0 + kk]; v.x *= gg; v.y *= gg; v.z *= gg; v.w *= gg; }
    }
    L[kk * 65 + n4] = v.x; L[kk * 65 + n4 + 1] = v.y; L[kk * 65 + n4 + 2] = v.z; L[kk * 65 + n4 + 3] = v.w;
  }
  __syncthreads();
  {
    const int n = tid >> 2, kq = tid & 3;
    float v[16];
#pragma unroll
    for (int j = 0; j < 16; ++j) v[j] = L[(kq * 16 + j) * 65 + n];
    uint4* d = (uint4*)(dst + (size_t)(n0 + n) * K + k0 + kq * 16);
    d[0] = pk8(v); d[1] = pk8(v + 8);
  }
  __syncthreads();
}

DI void phase0(const Params& p, char* lds) {
  const int tid = otid();
  u16* win = (u16*)(p.ws + W_WIN); u16* wout = (u16*)(p.ws + W_WOUT); u16* wpg = (u16*)(p.ws + W_WPG); u16* wpe = (u16*)(p.ws + W_WPE);
  for (int it = vbid(); it < DEPTH * 1312; it += vgrid()) {
    const int l = it / 1312; int j = it % 1312;
    if (j < 736) { transpose_item(p.w_in + (size_t)l * DM * NIN, DM, NIN, p.norm_g + l * DM, win + (size_t)l * NINP * DM, (j / 46) * 64, (j % 46) * 64, (float*)lds); }
    else if (j < 992) { j -= 736; transpose_item(p.w_out + (size_t)l * DM * DM, DM, DM, nullptr, wout + (size_t)l * DM * DM, (j / 16) * 64, (j % 16) * 64, (float*)lds); }
    else if (j < 1248) { j -= 992; transpose_item(p.w_pg + (size_t)l * DM * DM, DM, DM, p.pe_norm_g + l * DM, wpg + (size_t)l * DM * DM, (j / 16) * 64, (j % 16) * 64, (float*)lds); }
    else { j -= 1248; transpose_item(p.w_pe + (size_t)l * DPLE * DM, DPLE, DM, nullptr, wpe + (size_t)l * DM * DPLE, (j / 16) * 64, (j % 16) * 64, (float*)lds); }
  }
  u16* hb = (u16*)(p.ws + W_MIX);
  float* ssA = (float*)(p.ws + W_SSA);
  const size_t gt = (size_t)vbid() * NTHR + tid, gs = (size_t)vgrid() * NTHR;
#pragma unroll 4
  for (int row = vbid() * 4 + (tid >> 6); row < TT; row += vgrid() * 4) {
    const int lane = tid & 63;
    const float* s = (row < TP ? p.x_prompt + (size_t)row * DM : p.x_sample + (size_t)(row - TP) * DM) + lane * 8;
    float sq = 0.f;
#pragma unroll
    for (int hf = 0; hf < 2; ++hf) {
      const float4 f0 = *(const float4*)(s + hf * 512), f1 = *(const float4*)(s + hf * 512 + 4);
      sq += f0.x * f0.x + f0.y * f0.y + f0.z * f0.z + f0.w * f0.w + f1.x * f1.x + f1.y * f1.y + f1.z * f1.z + f1.w * f1.w;
      *(uint4*)(hb + (size_t)row * DM + hf * 512 + lane * 8) = make_uint4(pk2(f0.x, f0.y), pk2(f0.z, f0.w), pk2(f1.x, f1.y), pk2(f1.z, f1.w));
    }
    sq += __shfl_xor(sq, 1); sq += __shfl_xor(sq, 2); sq += __shfl_xor(sq, 4); sq += __shfl_xor(sq, 8); sq += __shfl_xor(sq, 16); sq += __shfl_xor(sq, 32);
    if (lane == 0) ssA[row] = sq;
  }
  float* rope = (float*)(p.ws + W_ROPE);
  for (size_t i = gt; i < (size_t)TP * 8; i += gs) {
    const int pos = (int)(i >> 3), fi = (int)(i & 7);
    float inv = 1.0f;
    switch (fi) {
      case 1: inv = 0.1939227432012558f; break; case 2: inv = 0.03760603070259094f; break; case 3: inv = 0.007292664609849453f; break;
      case 4: inv = 0.0014142135623842478f; break; case 5: inv = 0.00027424818836152554f; break; case 6: inv = 5.3182957344688475e-05f; break;
      case 7: inv = 1.0313385246263351e-05f; break; default: break;
    }
    const float angf = (float)pos * inv;
    const double a = (double)angf;
    const double q = rint(a * 0.63661977236758134308);
    double rr = fma(-q, 1.57079632679489655800e+00, a);
    rr = fma(-q, 6.12323399573676603587e-17, rr);
    const double r2 = rr * rr;
    const double sn = rr * (1.0 + r2 * (-1.0 / 6 + r2 * (1.0 / 120 + r2 * (-1.0 / 5040 + r2 * (1.0 / 362880 + r2 * (-1.0 / 39916800))))));
    const double cs = 1.0 + r2 * (-0.5 + r2 * (1.0 / 24 + r2 * (-1.0 / 720 + r2 * (1.0 / 40320 + r2 * (-1.0 / 3628800 + r2 * (1.0 / 479001600))))));
    const int qi = ((int)q) & 3;
    double c, s;
    if (qi == 0) { c = cs; s = sn; } else if (qi == 1) { c = -sn; s = cs; } else if (qi == 2) { c = -cs; s = -sn; } else { c = sn; s = -cs; }
    rope[pos * 16 + fi] = (float)c;
    rope[pos * 16 + 8 + fi] = (float)s;
  }
}

DI void store_rows_bf16(const float* C, const float* rstd, u16* dst, int ld, int m0, int coloff, float scale, bool silu) {
  const int tid = otid();
#pragma unroll 1
  for (int it = 0; it < 8; ++it) {
    const int item = it * 256 + tid, row = item >> 4, cgp = item & 15;
    const float rs = rstd[row] * scale;
    float v[8];
    const float4 a = *(const float4*)(C + row * 132 + cgp * 8), b = *(const float4*)(C + row * 132 + cgp * 8 + 4);
    v[0] = a.x * rs; v[1] = a.y * rs; v[2] = a.z * rs; v[3] = a.w * rs; v[4] = b.x * rs; v[5] = b.y * rs; v[6] = b.z * rs; v[7] = b.w * rs;
    if (silu) {
#pragma unroll
      for (int j = 0; j < 8; ++j) v[j] = siluf_(v[j]);
    }
    *(uint4*)(dst + (size_t)(m0 + row) * ld + coloff + cgp * 8) = pk8(v);
  }
}
DI void store_cols_bf16T(const float* C, const float* rstd, u16* dstT, int m0, int colbase) {
  const int tid = otid();
#pragma unroll 1
  for (int it = 0; it < 8; ++it) {
    const int item = it * 256 + tid, col = item & 127, rg = item >> 7;
    float v[8];
#pragma unroll
    for (int j = 0; j < 8; ++j) v[j] = C[(rg * 8 + j) * 132 + col] * rstd[rg * 8 + j];
    *(uint4*)(dstT + (size_t)(colbase + col) * TPS + m0 + rg * 8) = pk8(v);
  }
}
DI void store_rows_f32_kv(const float* C, const float* rstd, float* out, size_t off_p, size_t off_s, int l, int m0) {
  const int tid = otid();
#pragma unroll 1
  for (int it = 0; it < 8; ++it) {
    const int item = it * 256 + tid, row = item >> 4, cgp = item & 15;
    const int grow = m0 + row;
    float* d;
    if (grow >= TP) d = out + off_s + ((size_t)l * TS + (grow - TP)) * 128;
    else if (grow >= TP - 128) d = out + off_p + ((size_t)l * 128 + (grow - (TP - 128))) * 128;
    else continue;
    const float rs = rstd[row];
    const float4 a = *(const float4*)(C + row * 132 + cgp * 8), b = *(const float4*)(C + row * 132 + cgp * 8 + 4);
    *(float4*)(d + cgp * 8) = make_float4(a.x * rs, a.y * rs, a.z * rs, a.w * rs);
    *(float4*)(d + cgp * 8 + 4) = make_float4(b.x * rs, b.y * rs, b.z * rs, b.w * rs);
  }
}

DI void phaseA(const Params& p, int l, char* lds, int vb) {
  const int tid = otid();
  float* C = (float*)lds;
  float* rstd = (float*)(lds + 128 * 132 * 4);
  const u16* hb = (const u16*)(p.ws + W_MIX);
  const u16* wt = (const u16*)(p.ws + W_WIN) + (size_t)l * NINP * DM;
  const float* rope = (const float*)(p.ws + W_ROPE);
  const float* ssA = (const float*)(p.ws + W_SSA);
  { float* ssD = (float*)(p.ws + W_SSD); for (int i = vbid() * NTHR + tid; i < TT; i += vgrid() * NTHR) ssD[i] = 0.f; }
  for (int rnd = 0;; ++rnd) {
    const int spos = seq_pos(rnd, vb);
    if (rnd * vgrid() >= MT * 23) break;
    if (spos >= MT * 23) continue;
    int mt, nt; pos_to_tile(spos, MT, 23, 8, mt, nt);
    const int m0 = mt * 128, n0 = nt * 128;
    f32x16 acc[2][2];
    for (int i = 0; i < 2; ++i) for (int j = 0; j < 2; ++j) acc[i][j] = zero16();
    float ss[4] = {0.f, 0.f, 0.f, 0.f};
    gemm_main<false, false>(hb + (size_t)m0 * DM, DM, wt + (size_t)n0 * DM, DM, DM, acc, lds, ss);
    acc_to_lds(acc, C);
    if (tid < 128) rstd[tid] = rsqrtf(ssA[m0 + tid] * (1.f / DM) + 1e-6f);
    __syncthreads();
    if (n0 < 640) {
      const bool isq = n0 < 512;
      const float* gn = (isq ? p.q_norm_g : p.k_norm_g) + l * 64;
#pragma unroll 1
      for (int it = 0; it < 8; ++it) {
        const int item = it * 256 + tid, row = item >> 4, cgp = item & 15;
        const int grow = m0 + row, d0 = (cgp & 7) * 8;
        const float rs = rstd[row];
        float v[8];
        const float4 a = *(const float4*)(C + row * 132 + cgp * 8), b = *(const float4*)(C + row * 132 + cgp * 8 + 4);
        v[0] = a.x * rs; v[1] = a.y * rs; v[2] = a.z * rs; v[3] = a.w * rs; v[4] = b.x * rs; v[5] = b.y * rs; v[6] = b.z * rs; v[7] = b.w * rs;
        float s = 0.f;
#pragma unroll
        for (int j = 0; j < 8; ++j) s += v[j] * v[j];
        s += __shfl_xor(s, 1); s += __shfl_xor(s, 2); s += __shfl_xor(s, 4);
        const float hr = rsqrtf(s * (1.f / 64) + 1e-6f);
#pragma unroll
        for (int j = 0; j < 8; ++j) v[j] = v[j] * hr * gn[d0 + j];
        const int pos = grow < TP ? grow : 1024 + ((grow - TP) & 15);
        float pr[8];
#pragma unroll
        for (int j = 0; j < 8; ++j) pr[j] = __shfl_xor(v[j], 1);
        if ((cgp & 7) < 2) {
          const float4 c0 = *(const float4*)(rope + pos * 16), c1 = *(const float4*)(rope + pos * 16 + 4);
          const float4 s0 = *(const float4*)(rope + pos * 16 + 8), s1 = *(const float4*)(rope + pos * 16 + 12);
          const float cs[8] = {c0.x, c0.y, c0.z, c0.w, c1.x, c1.y, c1.z, c1.w};
          const float sn[8] = {s0.x, s0.y, s0.z, s0.w, s1.x, s1.y, s1.z, s1.w};
          const float sg = ((cgp & 7) == 0) ? -1.f : 1.f;
#pragma unroll
          for (int j = 0; j < 8; ++j) v[j] = v[j] * cs[j] + sg * pr[j] * sn[j];
        }
        if (isq) {
#pragma unroll
          for (int j = 0; j < 8; ++j) v[j] *= 0.125f;
          *(uint4*)((u16*)(p.ws + W_Q) + (size_t)grow * 512 + n0 + cgp * 8) = pk8(v);
        } else {
          *(uint4*)((u16*)(p.ws + W_K) + (size_t)grow * 128 + cgp * 8) = pk8(v);
          float* d = nullptr;
          if (grow >= TP) d = p.out + O_KS + ((size_t)l * TS + (grow - TP)) * 128;
          else if (grow >= TP - 128) d = p.out + O_KP + ((size_t)l * 128 + (grow - (TP - 128))) * 128;
          if (d) {
            *(float4*)(d + cgp * 8) = make_float4(v[0], v[1], v[2], v[3]);
            *(float4*)(d + cgp * 8 + 4) = make_float4(v[4], v[5], v[6], v[7]);
          }
        }
      }
    } else if (n0 == 640) {
      if (m0 < TP) store_cols_bf16T(C, rstd, (u16*)(p.ws + W_VT), m0, 0);
      if (m0 >= TP - 128) store_rows_f32_kv(C, rstd, p.out, O_VP, O_VS, l, m0);
    } else if (n0 < 1280) {
      store_rows_bf16(C, rstd, (u16*)(p.ws + W_GATE), DM, m0, n0 - 768, 1.f, true);
    } else if (n0 < 1536) {
      store_rows_bf16(C, rstd, (u16*)(p.ws + W_QB), 256, m0, n0 - 1280, 0.125f, false);
    } else if (n0 < 1792) {
      store_rows_bf16(C, rstd, (u16*)(p.ws + W_KB), 256, m0, n0 - 1536, 1.f, false);
      if (m0 < TP) store_cols_bf16T(C, rstd, (u16*)(p.ws + W_KBT), m0, n0 - 1536);
    } else if (n0 < 2304) {
      if (m0 < TP) store_cols_bf16T(C, rstd, (u16*)(p.ws + W_VBT), m0, n0 - 1792);
      else store_rows_bf16(C, rstd, (u16*)(p.ws + W_VBS), 512, m0 - TP, n0 - 1792, 1.f, false);
    } else if (n0 < 2816) {
      store_rows_bf16(C, rstd, (u16*)(p.ws + W_GATE), DM, m0, 512 + n0 - 2304, 1.f, true);
    } else {
      float* ab = (float*)(p.ws + W_AB);
      for (int item = tid; item < 128 * 4; item += 256) {
        const int row = item >> 2, c4 = item & 3;
        const float rs = rstd[row];
        const float4 a = *(const float4*)(C + row * 132 + c4 * 4);
        *(float4*)(ab + (size_t)(m0 + row) * 16 + c4 * 4) = make_float4(a.x * rs, a.y * rs, a.z * rs, a.w * rs);
      }
    }
    __syncthreads();
  }
}

namespace pg8 {
typedef float f32x4 __attribute__((ext_vector_type(4)));
constexpr int BM = 256, BK = 64, HALF = 128, HTB = HALF * BK * 2  , STAGE_BYTES = 8 * HTB, NXCD = 8, WGM = 8;
DI int lds_byte(int r, int c) { const int st = (r >> 4) * 2 + (c >> 5), rr = r & 15, cc = c & 31, ob = rr * 64 + cc * 2; return st * 1024 + (ob ^ (((ob >> 9) & 1) << 5)); }
DI void stage_rc(int b, int& R, int& C) { const int st = b / 1024, sb = b % 1024, swz = sb ^ (((sb >> 9) & 1) << 5); R = (st >> 1) * 16 + swz / 64; C = (st & 1) * 32 + (swz % 64) / 2; }
DI int perm32(int rho) { const int n = rho >> 4, i = rho & 15; return 8 * (i >> 2) + 4 * n + (i & 3); }
struct Unit { int pm, pn; };
struct Gemm { const u16* A; const u16* Bt; int M, N, K; };
struct StaticOrder {
  int nM, nN, nwg, G, c;
  DI void init(int M, int N, int G_, int c_) { nM = M / BM; nN = N / BM; nwg = nM * nN; G = G_; c = c_; }
  DI bool next(int i, Unit& u) const {
    const long L = (long)i * G + c; if (L >= nwg) return false;
    int wgid = (int)L; { const int q = nwg / NXCD, r = nwg % NXCD, xcd = wgid % NXCD, off = wgid / NXCD; wgid = (xcd < r ? xcd * (q + 1) : r * (q + 1) + (xcd - r) * q) + off; }
    const int nig = WGM * nN, gid = wgid / nig, fm = gid * WGM, gsz = (nM - fm) < WGM ? (nM - fm) : WGM;
    u.pm = fm + ((wgid % nig) % gsz); u.pn = (wgid % nig) / gsz; return true;
  }
};
template <class Epi>
DI void gemm_phase(LAS unsigned char* lds, const Gemm g, const StaticOrder& S, const Epi& E) {
  int tid_ = threadIdx.x; asm volatile("" : "+v"(tid_));
  const int tid = tid_, wid = __builtin_amdgcn_readfirstlane(tid >> 6), lane = tid & 63, wr = wid >> 2, wc = wid & 3, fr = lane & 15, fq = lane >> 4;
  const int K = g.K, nt = K / BK;
  unsigned voffA[2], voffB0[2];
#pragma unroll
  for (int i = 0; i < 2; ++i) { int R, C; stage_rc(tid * 16 + i * 8192, R, C); const int Rb = 64 * (R >> 5) + perm32(R & 31);
    voffA[i] = (unsigned)(R * K + C) * 2u; voffB0[i] = (unsigned)(Rb * K + C) * 2u; }
  const size_t b1off = (size_t)32 * K * 2;
  const size_t kstep = (size_t)(BK * 2);
  const size_t hstep = (size_t)HALF * K * 2;
  const size_t tstep = 2 * hstep;
  const unsigned ldsw = (unsigned)wid * 1024u;
  const int aoff = lds_byte(wr * 64 + fr, fq * 8), boff = lds_byte(wc * 32 + fr, fq * 8);
#define PG8_SA(b, h) (((b) * 2 + (h)) * HTB)
#define PG8_SB(b, h) ((4 + (b) * 2 + (h)) * HTB)
#define PG8_STAGE(bufoff, gbase, voff) do { _Pragma("unroll") for (int _i = 0; _i < 2; ++_i) \
    __builtin_amdgcn_global_load_lds((const unsigned*)((const char*)(gbase) + (voff)[_i]), (LAS unsigned*)(lds + (bufoff) + ldsw + _i * 8192), 16, 0, 0); } while (0)
#define PG8_LDA(dst, b, h) do { _Pragma("unroll") for (int m = 0; m < 4; ++m) _Pragma("unroll") for (int k = 0; k < 2; ++k) dst[m][k] = *(const LAS bf16x8*)(lds + PG8_SA(b, h) + aoff + m * 2048 + k * 1024); } while (0)
#define PG8_LDB(dst, b, h) do { _Pragma("unroll") for (int n = 0; n < 2; ++n) _Pragma("unroll") for (int k = 0; k < 2; ++k) dst[n][k] = *(const LAS bf16x8*)(lds + PG8_SB(b, h) + boff + n * 2048 + k * 1024); } while (0)
#define PG8_MMA(ai, bj, At, Bt) do { __builtin_amdgcn_s_setprio(1); _Pragma("unroll") for (int m = 0; m < 4; ++m) _Pragma("unroll") for (int n = 0; n < 2; ++n) _Pragma("unroll") for (int k = 0; k < 2; ++k) \
    acc[ai][bj][m][n] = __builtin_amdgcn_mfma_f32_16x16x32_bf16(Bt[n][k], At[m][k], acc[ai][bj][m][n], 0, 0, 0); __builtin_amdgcn_s_setprio(0); } while (0)
#define PG8_WAIT_V(n) asm volatile("s_waitcnt vmcnt(" #n ")" ::: "memory")
#define PG8_WAIT_L(n) asm volatile("s_waitcnt lgkmcnt(" #n ")" ::: "memory")
#define PG8_BAR __builtin_amdgcn_s_barrier()
#define PG8_SCHED __builtin_amdgcn_sched_barrier(0)
  Unit cur, nxt; int ui = 0;
  if (!S.next(0, cur)) return;
  f32x4 acc[2][2][4][2];
#pragma unroll
  for (int a = 0; a < 2; ++a)
#pragma unroll
    for (int b = 0; b < 2; ++b)
#pragma unroll
      for (int m = 0; m < 4; ++m)
#pragma unroll
        for (int n = 0; n < 2; ++n) acc[a][b][m][n] = (f32x4){0.f, 0.f, 0.f, 0.f};
  bf16x8 At[4][2], B0[2][2], B1[2][2];
  const char* cA = (const char*)g.A + (size_t)cur.pm * tstep; const char* cB = (const char*)g.Bt + (size_t)cur.pn * tstep;
  PG8_STAGE(PG8_SB(0, 0), cB, voffB0); PG8_STAGE(PG8_SA(0, 0), cA, voffA); PG8_STAGE(PG8_SB(0, 1), cB + b1off, voffB0); PG8_STAGE(PG8_SA(0, 1), cA + hstep, voffA);
  if (wr == 1) PG8_BAR;
  PG8_WAIT_V(4); PG8_BAR;
  PG8_STAGE(PG8_SB(1, 0), cB + kstep, voffB0); PG8_STAGE(PG8_SA(1, 0), cA + kstep, voffA); PG8_STAGE(PG8_SB(1, 1), cB + kstep + b1off, voffB0);
  PG8_WAIT_V(6); PG8_BAR;
  for (;;) {
    const bool has_next = S.next(ui + 1, nxt);
    const char* nA = has_next ? (const char*)g.A + (size_t)nxt.pm * tstep : cA; const char* nB = has_next ? (const char*)g.Bt + (size_t)nxt.pn * tstep : cB;
    for (int t = 0; t < nt; t += 2) {
      const bool last = (t == nt - 2);
      const char* a1 = cA + (size_t)(t + 1) * kstep;
      const char* a2 = last ? nA : cA + (size_t)(t + 2) * kstep; const char* b2 = last ? nB : cB + (size_t)(t + 2) * kstep;
      const char* a3 = a2 + kstep; const char* b3 = b2 + kstep;
      PG8_LDB(B0, 0, 0); PG8_SCHED; PG8_LDA(At, 0, 0); PG8_STAGE(PG8_SA(1, 1), a1 + hstep, voffA);
      PG8_WAIT_L(8); PG8_BAR; PG8_WAIT_L(0); PG8_MMA(0, 0, At, B0); PG8_BAR; PG8_SCHED;
      PG8_LDB(B1, 0, 1); PG8_STAGE(PG8_SB(0, 0), b2, voffB0);
      PG8_BAR; PG8_WAIT_L(0); PG8_MMA(0, 1, At, B1); PG8_BAR;
      PG8_LDA(At, 0, 1); PG8_STAGE(PG8_SA(0, 0), a2, voffA);
      PG8_BAR; PG8_WAIT_L(0); PG8_MMA(1, 0, At, B0); PG8_BAR; PG8_SCHED;
      PG8_STAGE(PG8_SB(0, 1), b2 + b1off, voffB0);
      PG8_WAIT_V(6); PG8_BAR; PG8_MMA(1, 1, At, B1); PG8_BAR;
      PG8_LDB(B0, 1, 0); PG8_SCHED; PG8_LDA(At, 1, 0); PG8_STAGE(PG8_SA(0, 1), a2 + hstep, voffA);
      PG8_WAIT_L(8); PG8_BAR; PG8_WAIT_L(0); PG8_MMA(0, 0, At, B0); PG8_BAR; PG8_SCHED;
      PG8_LDB(B1, 1, 1); PG8_STAGE(PG8_SB(1, 0), b3, voffB0);
      PG8_BAR; PG8_WAIT_L(0); PG8_MMA(0, 1, At, B1); PG8_BAR;
      PG8_LDA(At, 1, 1); PG8_STAGE(PG8_SA(1, 0), a3, voffA);
      PG8_BAR; PG8_WAIT_L(0); PG8_MMA(1, 0, At, B0); PG8_BAR; PG8_SCHED;
      PG8_STAGE(PG8_SB(1, 1), b3 + b1off, voffB0);
      PG8_WAIT_V(6); PG8_BAR; PG8_MMA(1, 1, At, B1); PG8_BAR;
    }
    E(acc, cur, wr, wc, fr, fq);
    if (!has_next) break;
#pragma unroll
    for (int a = 0; a < 2; ++a)
#pragma unroll
      for (int b = 0; b < 2; ++b)
#pragma unroll
        for (int m = 0; m < 4; ++m)
#pragma unroll
          for (int n = 0; n < 2; ++n) acc[a][b][m][n] = (f32x4){0.f, 0.f, 0.f, 0.f};
    cur = nxt; cA = nA; cB = nB; ++ui;
  }
  PG8_WAIT_V(0);
  if (wr == 0) PG8_BAR;
  PG8_BAR;
#undef PG8_SA
#undef PG8_SB
#undef PG8_STAGE
#undef PG8_LDA
#undef PG8_LDB
#undef PG8_MMA
#undef PG8_WAIT_V
#undef PG8_WAIT_L
#undef PG8_BAR
#undef PG8_SCHED
}
}

DI u16 bf1(float x) { return (u16)(pk2(x, 0.f) & 0xffffu); }
struct EpiA {
  char* ws; float* out; const float* qng; const float* kng; int l;
  template <int SEG>
  DI void rows(const pg8::f32x4 (&acc)[2][2][4][2], const pg8::Unit& u, int cb, int wr, int fr, int fq) const {
    const float* ssA = (const float*)(ws + W_SSA);
    const bool sample = u.pm >= TP / 256;
    const int c0 = 8 * fq;
    float rsv[8];
#pragma unroll
    for (int i = 0; i < 8; ++i) rsv[i] = ssA[u.pm * 256 + (i >> 2) * 128 + wr * 64 + (i & 3) * 16 + fr];
#pragma unroll
    for (int i = 0; i < 8; ++i) rsv[i] = rsqrtf(rsv[i] * (1.f / DM) + 1e-6f);
#pragma unroll
    for (int ai = 0; ai < 2; ++ai)
#pragma unroll
      for (int m = 0; m < 4; ++m) {
        const int row = u.pm * 256 + ai * 128 + wr * 64 + m * 16 + fr;
        const float rs = rsv[ai * 4 + m];
        float x[2][8];
#pragma unroll
        for (int bj = 0; bj < 2; ++bj)
#pragma unroll
          for (int n = 0; n < 2; ++n)
#pragma unroll
            for (int j = 0; j < 4; ++j) x[bj][4 * n + j] = acc[ai][bj][m][n][j] * rs;
        if (SEG < 2) {
          float sq = 0.f;
#pragma unroll
          for (int bj = 0; bj < 2; ++bj)
#pragma unroll
            for (int e = 0; e < 8; ++e) sq += x[bj][e] * x[bj][e];
          sq += __shfl_xor(sq, 16); sq += __shfl_xor(sq, 32);
          const float hr = rsqrtf(sq * (1.f / 64) + 1e-6f);
          const float* gp = (SEG == 0 ? qng : kng) + c0;
#pragma unroll
          for (int bj = 0; bj < 2; ++bj) {
            const float4 a = *(const float4*)(gp + 32 * bj), b = *(const float4*)(gp + 32 * bj + 4);
            x[bj][0] *= hr * a.x; x[bj][1] *= hr * a.y; x[bj][2] *= hr * a.z; x[bj][3] *= hr * a.w;
            x[bj][4] *= hr * b.x; x[bj][5] *= hr * b.y; x[bj][6] *= hr * b.z; x[bj][7] *= hr * b.w;
          }
          const int pos = row < TP ? row : 1024 + ((row - TP) & 15);
          const float* rp = (const float*)(ws + W_ROPE) + pos * 16;
          float rpc[16];
#pragma unroll
          for (int e = 0; e < 16; e += 4) { const float4 t = *(const float4*)(rp + e); rpc[e] = t.x; rpc[e + 1] = t.y; rpc[e + 2] = t.z; rpc[e + 3] = t.w; }
          const float sg = fq == 0 ? -1.f : 1.f;
#pragma unroll
          for (int e = 0; e < 8; ++e) {
            const float pr = __shfl_xor(x[0][e], 16);
            if (fq < 2) x[0][e] = x[0][e] * rpc[e] + sg * pr * rpc[8 + e];
          }
          if (SEG == 0) {
#pragma unroll
            for (int bj = 0; bj < 2; ++bj) {
#pragma unroll
              for (int e = 0; e < 8; ++e) x[bj][e] *= 0.125f;
              *(uint4*)((u16*)(ws + W_Q) + (size_t)row * 512 + cb + 32 * bj + c0) = pk8(x[bj]);
            }
          } else {
            const int kc = cb - 512;
            float* d = nullptr;
            if (row >= TP) d = out + O_KS + ((size_t)l * TS + (row - TP)) * 128;
            else if (row >= TP - 128) d = out + O_KP + ((size_t)l * 128 + (row - (TP - 128))) * 128;
#pragma unroll
            for (int bj = 0; bj < 2; ++bj) {
              *(uint4*)((u16*)(ws + W_K) + (size_t)row * 128 + kc + 32 * bj + c0) = pk8(x[bj]);
              if (d) { *(float4*)(d + kc + 32 * bj + c0) = make_float4(x[bj][0], x[bj][1], x[bj][2], x[bj][3]); *(float4*)(d + kc + 32 * bj + c0 + 4) = make_float4(x[bj][4], x[bj][5], x[bj][6], x[bj][7]); }
            }
          }
        } else if (SEG == 2) {
          const int vc = cb - 640;
          float* d = nullptr;
          if (row >= TP) d = out + O_VS + ((size_t)l * TS + (row - TP)) * 128;
          else if (row >= TP - 128) d = out + O_VP + ((size_t)l * 128 + (row - (TP - 128))) * 128;
#pragma unroll
          for (int bj = 0; bj < 2; ++bj) {
            if (!sample) {
              u16* vT = (u16*)(ws + W_VT) + tidx(128, vc + 32 * bj + c0, row);
#pragma unroll
              for (int e = 0; e < 8; ++e) vT[e * 64] = bf1(x[bj][e]);
            }
            if (d) { *(float4*)(d + vc + 32 * bj + c0) = make_float4(x[bj][0], x[bj][1], x[bj][2], x[bj][3]); *(float4*)(d + vc + 32 * bj + c0 + 4) = make_float4(x[bj][4], x[bj][5], x[bj][6], x[bj][7]); }
          }
        } else if (SEG == 3 || SEG == 7) {
          const int gc = SEG == 3 ? cb - 768 : 512 + cb - 2304;
#pragma unroll
          for (int bj = 0; bj < 2; ++bj) {
#pragma unroll
            for (int e = 0; e < 8; ++e) x[bj][e] = siluf_(x[bj][e]);
            *(uint4*)((u16*)(ws + W_GATE) + (size_t)row * DM + gc + 32 * bj + c0) = pk8(x[bj]);
          }
        } else if (SEG == 4) {
#pragma unroll
          for (int bj = 0; bj < 2; ++bj) {
#pragma unroll
            for (int e = 0; e < 8; ++e) x[bj][e] *= 0.125f;
            *(uint4*)((u16*)(ws + W_QB) + (size_t)row * 256 + (cb - 1280) + 32 * bj + c0) = pk8(x[bj]);
          }
        } else if (SEG == 5) {
#pragma unroll
          for (int bj = 0; bj < 2; ++bj) {
            *(uint4*)((u16*)(ws + W_KB) + (size_t)row * 256 + (cb - 1536) + 32 * bj + c0) = pk8(x[bj]);
            if (!sample) {
              u16* kT = (u16*)(ws + W_KBT) + tidx(256, cb - 1536 + 32 * bj + c0, row);
#pragma unroll
              for (int e = 0; e < 8; ++e) kT[e * 64] = bf1(x[bj][e]);
            }
          }
        } else {
#pragma unroll
          for (int bj = 0; bj < 2; ++bj) {
            if (!sample) {
              u16* vT = (u16*)(ws + W_VBT) + tidx(512, cb - 1792 + 32 * bj + c0, row);
#pragma unroll
              for (int e = 0; e < 8; ++e) vT[e * 64] = bf1(x[bj][e]);
            } else {
              *(uint4*)((u16*)(ws + W_VBS) + (size_t)(row - TP) * 512 + (cb - 1792) + 32 * bj + c0) = pk8(x[bj]);
            }
          }
        }
        if (m & 1) asm volatile("" ::: "memory");
      }
  }
  DI void operator()(const pg8::f32x4 (&acc)[2][2][4][2], const pg8::Unit& u, int wr, int wc, int fr, int fq) const {
    const int cb = u.pn * 256 + wc * 64;
    if (cb < 512) rows<0>(acc, u, cb, wr, fr, fq);
    else if (cb < 640) rows<1>(acc, u, cb, wr, fr, fq);
    else if (cb < 768) rows<2>(acc, u, cb, wr, fr, fq);
    else if (cb < 1280) rows<3>(acc, u, cb, wr, fr, fq);
    else if (cb < 1536) rows<4>(acc, u, cb, wr, fr, fq);
    else if (cb < 1792) rows<5>(acc, u, cb, wr, fr, fq);
    else if (cb < 2304) rows<6>(acc, u, cb, wr, fr, fq);
    else rows<7>(acc, u, cb, wr, fr, fq);
  }
};

DI void phaseA8(const Params& p, int l, char* lds_all) {
  { int t0 = threadIdx.x; asm volatile("" : "+v"(t0));
    float* ssD = (float*)(p.ws + W_SSD);
    const int per = (TT + (int)gridDim.x - 1) / (int)gridDim.x, i = (int)blockIdx.x * per + t0;
    if (t0 < per && i < TT) ssD[i] = 0.f; }
  const u16* hb = (const u16*)(p.ws + W_MIX);
  const u16* wt = (const u16*)(p.ws + W_WIN) + (size_t)l * NINP * DM;
  pg8::Gemm g{hb, wt, TT, 2816, DM};
  pg8::StaticOrder S; S.init(TT, 2816, (int)gridDim.x, obid());
  EpiA E{p.ws, p.out, p.q_norm_g + l * 64, p.k_norm_g + l * 64, l};
  pg8::gemm_phase<EpiA>((LAS unsigned char*)lds_all, g, S, E);
  {
    int t2 = threadIdx.x; asm volatile("" : "+v"(t2));
    const int wid = t2 >> 6, lane = t2 & 63, r = lane & 31, hh = lane >> 5;
    const int gw = ((int)gridDim.x - 1 - (int)blockIdx.x) * 8 + wid;
    if (gw < TT / 32) {
      const int row0 = gw * 32;
      const u16* ap = hb + (size_t)(row0 + r) * DM + 8 * hh;
      const u16* bp = wt + (size_t)(2816 + r) * DM + 8 * hh;
      f32x16 acc = zero16();
#pragma unroll 16
      for (int ks = 0; ks < 64; ++ks) acc = MFMA(*(const bf16x8*)(ap + ks * 16), *(const bf16x8*)(bp + ks * 16), acc);
      const float* ssA = (const float*)(p.ws + W_SSA);
      float* ab = (float*)(p.ws + W_AB);
      if (r < 16) {
#pragma unroll
        for (int gi = 0; gi < 16; ++gi) { const int row = row0 + crow(gi, hh); ab[(size_t)row * 16 + r] = acc[gi] * rsqrtf(ssA[row] * (1.f / DM) + 1e-6f); }
      }
    }
  }
}

DI void phaseB(const Params& p, int l, char* lds) {
  const int tid = otid(), lane = tid & 63, w = tid >> 6, r = lane & 31, hh = lane >> 5;
  float* bN = (float*)lds;
  float* bT = bN + 64 * 65;
  float* tot = bT + 64 * 68;
  float* blast = tot + 256;
  const float* ab = (const float*)(p.ws + W_AB);
  u16* qb = (u16*)(p.ws + W_QB); u16* kb = (u16*)(p.ws + W_KB);
  const u16* kbT = (const u16*)(p.ws + W_KBT); const u16* vbT = (const u16*)(p.ws + W_VBT);
  float* Sb = (float*)(p.ws + W_S); float* dec = (float*)(p.ws + W_DEC);
  { float* ssA = (float*)(p.ws + W_SSA);
    const int per = (TT + vgrid() - 1) / vgrid(), i = vbid() * per + tid;
    if (tid < per && i < TT) ssA[i] = 0.f; }
  for (int item = vbid(); item < NCH * 4; item += vgrid()) {
    const int c = item >> 2, h = item & 3;
    {
      const int k = tid & 63, g = tid >> 6;
      float wg[16];
#pragma unroll
      for (int j = 0; j < 16; ++j) wg[j] = p.w_gate_up[((size_t)l * 16 + j) * 256 + h * 64 + k];
      const float bias = p.b_gate[l * 256 + h * 64 + k];
      float loc[16]; float cum = 0.f;
#pragma unroll
      for (int i = 0; i < 16; ++i) {
        const float* a = ab + (size_t)(c * 64 + g * 16 + i) * 16;
        const float4 a0 = *(const float4*)a, a1 = *(const float4*)(a + 4), a2 = *(const float4*)(a + 8), a3 = *(const float4*)(a + 12);
        float z = bias + a0.x * wg[0] + a0.y * wg[1] + a0.z * wg[2] + a0.w * wg[3] + a1.x * wg[4] + a1.y * wg[5] + a1.z * wg[6] + a1.w * wg[7]
                  + a2.x * wg[8] + a2.y * wg[9] + a2.z * wg[10] + a2.w * wg[11] + a3.x * wg[12] + a3.y * wg[13] + a3.z * wg[14] + a3.w * wg[15];
        cum += logsigmoidf_(z) * (1.f / 16);
        loc[i] = cum;
      }
      tot[g * 64 + k] = cum;
      __syncthreads();
      float off = 0.f;
      for (int g2 = 0; g2 < g; ++g2) off += tot[g2 * 64 + k];
#pragma unroll
      for (int i = 0; i < 16; ++i) {
        const int t = g * 16 + i; const float bv = loc[i] + off;
        bN[t * 65 + k] = bv; bT[k * 68 + t] = bv;
      }
      if (g == 3) { const float bl = loc[15] + off; blast[k] = bl; dec[(size_t)item * 64 + k] = __expf(bl); }
      __syncthreads();
    }
#pragma unroll
    for (int i = 0; i < 2; ++i) {
      const int grp = tid + 256 * i, t = grp >> 3, kc = grp & 7;
      const size_t off = (size_t)(c * 64 + t) * 256 + h * 64 + kc * 8;
      float qv[8], kv[8];
      unpk8(*(const uint4*)(qb + off), qv); unpk8(*(const uint4*)(kb + off), kv);
#pragma unroll
      for (int j = 0; j < 8; ++j) { const float bb = bN[t * 65 + kc * 8 + j]; qv[j] *= __expf(bb); kv[j] *= __expf(-bb); }
      *(uint4*)(qb + off) = pk8(qv); *(uint4*)(kb + off) = pk8(kv);
    }
    {
      f32x16 acc[2] = {zero16(), zero16()};
#pragma unroll
      for (int s = 0; s < 4; ++s) {
        const int t0 = 16 * s + 8 * hh;
        const bf16x8 vf = *(const bf16x8*)(vbT + tidx(512, h * 128 + w * 32 + r, c * 64 + t0));
#pragma unroll
        for (int kt = 0; kt < 2; ++kt) {
          const int k = kt * 32 + r;
          float kv[8];
          unpk8(*(const uint4*)(kbT + tidx(256, h * 64 + k, c * 64 + t0)), kv);
          const float bl = blast[k];
          const float4 b0 = *(const float4*)(bT + k * 68 + t0), b1 = *(const float4*)(bT + k * 68 + t0 + 4);
          kv[0] *= __expf(bl - b0.x); kv[1] *= __expf(bl - b0.y); kv[2] *= __expf(bl - b0.z); kv[3] *= __expf(bl - b0.w);
          kv[4] *= __expf(bl - b1.x); kv[5] *= __expf(bl - b1.y); kv[6] *= __expf(bl - b1.z); kv[7] *= __expf(bl - b1.w);
          acc[kt] = MFMA(vf, as_frag(pk8(kv)), acc[kt]);
        }
      }
#pragma unroll
      for (int kt = 0; kt < 2; ++kt)
#pragma unroll
        for (int g = 0; g < 16; ++g) Sb[(size_t)item * 8192 + (size_t)(w * 32 + crow(g, hh)) * 64 + kt * 32 + r] = acc[kt][g];
    }
    __syncthreads();
  }
}

DI void scan_item(const Params& p, int l, int it) {
  const int e = it * 256 + otid();
  const int h = e >> 13, v = (e >> 6) & 127, k = e & 63;
  float* Sb = (float*)(p.ws + W_S) + e;
  const float* dec = (const float*)(p.ws + W_DEC) + h * 64 + k;
  float S = 0.f;
  for (int c0 = 0; c0 < NCH; c0 += 16) {
    float d[16], g[16];
#pragma unroll
    for (int j = 0; j < 16; ++j) { d[j] = Sb[(size_t)(c0 + j) * 32768]; g[j] = dec[(size_t)(c0 + j) * 256]; }
#pragma unroll
    for (int j = 0; j < 16; ++j) { Sb[(size_t)(c0 + j) * 32768] = S; S = g[j] * S + d[j]; }
  }
  p.out[O_SP + (size_t)l * 32768 + h * 8192 + k * 128 + v] = S;
}

DI void attn_prompt_item(const Params& p, int l, int item, char* lds) {
  const int tid = otid(), lane = tid & 63, w = tid >> 6, r = lane & 31, hh = lane >> 5;
  const int c = item >> 2, kvh = (item >> 1) & 1, hp = item & 1;
  const int hq = kvh * 4 + hp * 2 + (w >> 1), qt = w & 1;
  const u16* q = (const u16*)(p.ws + W_Q); const u16* kbuf = (const u16*)(p.ws + W_K); const u16* vT = (const u16*)(p.ws + W_VT);
  const u16* gate = (const u16*)(p.ws + W_GATE); u16* mix = (u16*)(p.ws + W_MIX);
  const int qtok = c * 64 + qt * 32 + r;
  const int kt0 = c >= 2 ? 0 : (2 - c) * 2;
  const int kbase = (c - 2) * 64;
  char* Ks = lds;
  char* Vs = lds + 24576;
  char* Qs = lds + 49152 + w * 4096;
  {
    uint4 kr[6], vr[6], qr[4];
#pragma unroll
    for (int i = 0; i < 6; ++i) {
      const int idx = i * 256 + tid, row = idx >> 3, c16 = idx & 7;
      kr[i] = *(const uint4*)(kbuf + (size_t)max(kbase + row, 0) * 128 + kvh * 64 + c16 * 8);
      const int jc = max(c - 2 + (row >> 6), 0);
      vr[i] = *(const uint4*)(vT + ((size_t)jc * 128 + kvh * 64 + (row & 63)) * 64 + c16 * 8);
    }
#pragma unroll
    for (int i = 0; i < 4; ++i) {
      const int idx = i * 64 + lane, row = idx >> 3, c16 = idx & 7;
      qr[i] = *(const uint4*)(q + (size_t)(c * 64 + qt * 32 + row) * 512 + hq * 64 + c16 * 8);
    }
#pragma unroll
    for (int i = 0; i < 6; ++i) {
      const int idx = i * 256 + tid, row = idx >> 3, c16 = idx & 7;
      *(uint4*)(Ks + row * 128 + ((c16 ^ ((row >> 1) & 7)) << 4)) = kr[i];
      *(uint4*)(Vs + row * 128 + ((c16 ^ (row & 7)) << 4)) = vr[i];
    }
#pragma unroll
    for (int i = 0; i < 4; ++i) {
      const int idx = i * 64 + lane, row = idx >> 3, c16 = idx & 7;
      *(uint4*)(Qs + row * 128 + ((c16 ^ ((row >> 1) & 7)) << 4)) = qr[i];
    }
  }
  __syncthreads();
  bf16x8 qf[4];
#pragma unroll
  for (int ks = 0; ks < 4; ++ks) qf[ks] = *(const bf16x8*)(Qs + r * 128 + (((2 * ks + hh) ^ ((r >> 1) & 7)) << 4));
  f32x16 s[6];
#pragma unroll
  for (int kt = 0; kt < 6; ++kt) {
    s[kt] = zero16();
    const int krow = kt * 32 + r;
#pragma unroll
    for (int ks = 0; ks < 4; ++ks) s[kt] = MFMA(*(const bf16x8*)(Ks + krow * 128 + (((2 * ks + hh) ^ ((krow >> 1) & 7)) << 4)), qf[ks], s[kt]);
  }
  uint2 gpre[8];
#pragma unroll
  for (int i = 0; i < 8; ++i) gpre[i] = *(const uint2*)(gate + (size_t)qtok * DM + hq * 64 + (i >> 2) * 32 + 8 * (i & 3) + 4 * hh);
  const float sink = p.sinks[l * 8 + hq];
  float m = sink;
#pragma unroll
  for (int kt = 0; kt < 6; ++kt) {
    const float msk = kt >= kt0 ? 0.f : -1e30f;
#pragma unroll
    for (int g = 0; g < 16; ++g) { s[kt][g] += msk; m = fmaxf(m, s[kt][g]); }
  }
  m = fmaxf(m, __shfl_xor(m, 32));
  float den = 0.f;
#pragma unroll
  for (int kt = 0; kt < 6; ++kt) {
#pragma unroll
    for (int g = 0; g < 16; ++g) { const float e = __expf(s[kt][g] - m); s[kt][g] = e; den += e; }
  }
  den += __shfl_xor(den, 32);
  den += __expf(sink - m);
  f32x16 o[2] = {zero16(), zero16()};
#pragma unroll
  for (int kt = 0; kt < 6; ++kt) {
#pragma unroll
    for (int s2 = 0; s2 < 2; ++s2) {
      const uint4 pf = make_uint4(pk2(s[kt][8 * s2], s[kt][8 * s2 + 1]), pk2(s[kt][8 * s2 + 2], s[kt][8 * s2 + 3]),
                                  pk2(s[kt][8 * s2 + 4], s[kt][8 * s2 + 5]), pk2(s[kt][8 * s2 + 6], s[kt][8 * s2 + 7]));
      const int slot = 8 * (kt & 1) + 4 * s2 + hh;
#pragma unroll
      for (int dt = 0; dt < 2; ++dt) {
        const int vrow = (kt >> 1) * 64 + dt * 32 + r;
        const char* vp = Vs + vrow * 128 + (slot & 1) * 8;
        const uint2 lo = *(const uint2*)(vp + ((((slot >> 1)) ^ (vrow & 7)) << 4)), hi = *(const uint2*)(vp + ((((slot >> 1) + 1) ^ (vrow & 7)) << 4));
        o[dt] = MFMA(as_frag(make_uint4(lo.x, lo.y, hi.x, hi.y)), as_frag(pf), o[dt]);
      }
    }
  }
  const float inv = 1.f / den;
#pragma unroll
  for (int dt = 0; dt < 2; ++dt)
#pragma unroll
    for (int g4 = 0; g4 < 4; ++g4) {
      const size_t off = (size_t)qtok * DM + hq * 64 + dt * 32 + 8 * g4 + 4 * hh;
      const uint2 gv = gpre[dt * 4 + g4];
      const float o0 = o[dt][4 * g4] * inv * bflo(gv.x), o1 = o[dt][4 * g4 + 1] * inv * bfhi(gv.x);
      const float o2 = o[dt][4 * g4 + 2] * inv * bflo(gv.y), o3 = o[dt][4 * g4 + 3] * inv * bfhi(gv.y);
      *(uint2*)(mix + off) = make_uint2(pk2(o0, o1), pk2(o2, o3));
    }
  __syncthreads();
}

DI void attn_sample_item(const Params& p, int l, int item, char* lds) {
  const int tid = otid();
  const int b = item >> 3, hq = item & 7, kvh = hq >> 2;
  float* sc = (float*)lds;
  float* qs = sc + 16 * 148;
  char* Ksm = lds + 13824;
  char* Vsm = Ksm + 144 * 144;
  const int t = tid >> 4, part = tid & 15;
  const int row = TP + b * 16 + t;
  const float* ck = p.cache_k + ((size_t)(l * 32 + b) * 128) * 128 + kvh * 64;
  const float* cv = p.cache_v + ((size_t)(l * 32 + b) * 128) * 128 + kvh * 64;
  const float* nk = p.out + O_KS + ((size_t)l * TS + b * 16) * 128 + kvh * 64;
  const float* nv = p.out + O_VS + ((size_t)l * TS + b * 16) * 128 + kvh * 64;
  {
    const u16* q = (const u16*)(p.ws + W_Q) + (size_t)row * 512 + hq * 64 + part * 4;
    const uint2 u = *(const uint2*)q;
    *(float4*)(qs + t * 68 + part * 4) = make_float4(bflo(u.x), bfhi(u.x), bflo(u.y), bfhi(u.y));
    float4 kr[9], vr[9];
#pragma unroll
    for (int i = 0; i < 9; ++i) {
      const int idx = i * 256 + tid, key = idx >> 4, c4 = idx & 15;
      kr[i] = *(const float4*)((key < 128 ? ck + (size_t)key * 128 : nk + (size_t)(key - 128) * 128) + c4 * 4);
      vr[i] = *(const float4*)((key < 128 ? cv + (size_t)key * 128 : nv + (size_t)(key - 128) * 128) + c4 * 4);
    }
#pragma unroll
    for (int i = 0; i < 9; ++i) {
      const int idx = i * 256 + tid, key = idx >> 4, c4 = idx & 15;
      *(uint2*)(Ksm + key * 144 + c4 * 8) = make_uint2(pk2(kr[i].x, kr[i].y), pk2(kr[i].z, kr[i].w));
      *(uint2*)(Vsm + key * 128 + c4 * 8) = make_uint2(pk2(vr[i].x, vr[i].y), pk2(vr[i].z, vr[i].w));
    }
  }
  __syncthreads();
  {
    float a[9];
#pragma unroll
    for (int i = 0; i < 9; ++i) a[i] = 0.f;
#pragma unroll 2
    for (int d = 0; d < 64; d += 8) {
      const float4 q0 = *(const float4*)(qs + t * 68 + d), q1 = *(const float4*)(qs + t * 68 + d + 4);
#pragma unroll
      for (int i = 0; i < 9; ++i) {
        float kv[8]; unpk8(*(const uint4*)(Ksm + (part * 9 + i) * 144 + d * 2), kv);
        a[i] += q0.x * kv[0] + q0.y * kv[1] + q0.z * kv[2] + q0.w * kv[3] + q1.x * kv[4] + q1.y * kv[5] + q1.z * kv[6] + q1.w * kv[7];
      }
    }
#pragma unroll
    for (int i = 0; i < 9; ++i) sc[t * 148 + part * 9 + i] = a[i];
  }
  const float sink = p.sinks[l * 8 + hq];
  float m = sink;
#pragma unroll
  for (int i = 0; i < 9; ++i) m = fmaxf(m, sc[t * 148 + part * 9 + i]);
  m = fmaxf(m, __shfl_xor(m, 1)); m = fmaxf(m, __shfl_xor(m, 2)); m = fmaxf(m, __shfl_xor(m, 4)); m = fmaxf(m, __shfl_xor(m, 8));
  float den = 0.f;
#pragma unroll
  for (int i = 0; i < 9; ++i) { const float e = __expf(sc[t * 148 + part * 9 + i] - m); den += e; sc[t * 148 + part * 9 + i] = e; }
  den += __shfl_xor(den, 1); den += __shfl_xor(den, 2); den += __shfl_xor(den, 4); den += __shfl_xor(den, 8);
  den += __expf(sink - m);
  __syncthreads();
  float o0 = 0.f, o1 = 0.f, o2 = 0.f, o3 = 0.f;
#pragma unroll 16
  for (int key = 0; key < 144; ++key) {
    const float pw = sc[t * 148 + key];
    const uint2 vv = *(const uint2*)(Vsm + key * 128 + part * 8);
    o0 += pw * bflo(vv.x); o1 += pw * bfhi(vv.x); o2 += pw * bflo(vv.y); o3 += pw * bfhi(vv.y);
  }
  const float inv = 1.f / den;
  const size_t off = (size_t)row * DM + hq * 64 + part * 4;
  const uint2 gv = *(const uint2*)((const u16*)(p.ws + W_GATE) + off);
  o0 *= inv * bflo(gv.x); o1 *= inv * bfhi(gv.x); o2 *= inv * bflo(gv.y); o3 *= inv * bfhi(gv.y);
  *(uint2*)((u16*)(p.ws + W_MIX) + off) = make_uint2(pk2(o0, o1), pk2(o2, o3));
  __syncthreads();
}

DI void gla_out_prompt(const Params& p, int l, int item, char* lds) {
  const int tid = otid(), lane = tid & 63, w = tid >> 6, r = lane & 31, hh = lane >> 5;
  const int c = item >> 2, h = item & 3;
  const int tt = w & 1, vh = w >> 1;
  char* Qs = lds;
  char* Ks = lds + 8192;
  char* Vs = lds + 16384;
  char* Ss = lds + 32768;
  char* Gs = lds + 49152;
  float* part = (float*)(lds + 65536);
  char* Os = lds;
  const u16* qtb = (const u16*)(p.ws + W_QB); const u16* ktb = (const u16*)(p.ws + W_KB); const u16* vbT = (const u16*)(p.ws + W_VBT);
  const float* Sb = (const float*)(p.ws + W_S) + (size_t)item * 8192;
  const u16* gate = (const u16*)(p.ws + W_GATE); u16* mix = (u16*)(p.ws + W_MIX);
  {
    uint4 qr[2], kr[2], vr[4], gr[4]; float4 sr[8];
#pragma unroll
    for (int i = 0; i < 2; ++i) {
      const int idx = i * 256 + tid, row = idx >> 3, c16 = idx & 7;
      qr[i] = *(const uint4*)(qtb + (size_t)(c * 64 + row) * 256 + h * 64 + c16 * 8);
      kr[i] = *(const uint4*)(ktb + (size_t)(c * 64 + row) * 256 + h * 64 + c16 * 8);
    }
#pragma unroll
    for (int i = 0; i < 4; ++i) {
      const int idx = i * 256 + tid, row = idx >> 3, c16 = idx & 7;
      vr[i] = *(const uint4*)(vbT + ((size_t)c * 512 + h * 128 + row) * 64 + c16 * 8);
      sr[2 * i] = *(const float4*)(Sb + (size_t)row * 64 + c16 * 8); sr[2 * i + 1] = *(const float4*)(Sb + (size_t)row * 64 + c16 * 8 + 4);
      const int grow = idx >> 4, g16 = idx & 15;
      gr[i] = *(const uint4*)(gate + (size_t)(c * 64 + grow) * DM + 512 + h * 128 + g16 * 8);
    }
#pragma unroll
    for (int i = 0; i < 2; ++i) {
      const int idx = i * 256 + tid, row = idx >> 3, c16 = idx & 7;
      *(uint4*)(Qs + row * 128 + ((c16 ^ ((row >> 1) & 7)) << 4)) = qr[i];
      *(uint4*)(Ks + row * 128 + ((c16 ^ ((row >> 1) & 7)) << 4)) = kr[i];
    }
#pragma unroll
    for (int i = 0; i < 4; ++i) {
      const int idx = i * 256 + tid, row = idx >> 3, c16 = idx & 7;
      *(uint4*)(Vs + row * 128 + ((c16 ^ (row & 7)) << 4)) = vr[i];
      *(uint4*)(Ss + row * 128 + ((c16 ^ ((row >> 1) & 7)) << 4)) = make_uint4(pk2(sr[2 * i].x, sr[2 * i].y), pk2(sr[2 * i].z, sr[2 * i].w), pk2(sr[2 * i + 1].x, sr[2 * i + 1].y), pk2(sr[2 * i + 1].z, sr[2 * i + 1].w));
      *(uint4*)(Gs + idx * 16) = gr[i];
    }
  }
  __syncthreads();
  const int t = tt * 32 + r, tok = c * 64 + t;
  bf16x8 qf[4];
#pragma unroll
  for (int ks = 0; ks < 4; ++ks) qf[ks] = *(const bf16x8*)(Qs + t * 128 + (((2 * ks + hh) ^ ((t >> 1) & 7)) << 4));
  f32x16 x0 = zero16(), x1 = zero16();
#pragma unroll
  for (int ks = 0; ks < 4; ++ks) {
    x0 = MFMA(*(const bf16x8*)(Ks + r * 128 + (((2 * ks + hh) ^ ((r >> 1) & 7)) << 4)), qf[ks], x0);
    x1 = MFMA(*(const bf16x8*)(Ks + (32 + r) * 128 + (((2 * ks + hh) ^ (((32 + r) >> 1) & 7)) << 4)), qf[ks], x1);
  }
#pragma unroll
  for (int g = 0; g < 16; ++g) {
    const bool keep = crow(g, hh) <= r;
    if (tt == 0) { if (!keep) x0[g] = 0.f; x1[g] = 0.f; } else { if (!keep) x1[g] = 0.f; }
  }
  f32x16 o[2] = {zero16(), zero16()};
#pragma unroll
  for (int vt = 0; vt < 2; ++vt) {
    const int v = (2 * vh + vt) * 32 + r;
#pragma unroll
    for (int st = 0; st < 2; ++st)
#pragma unroll
      for (int s2 = 0; s2 < 2; ++s2) {
        const f32x16& xx = st == 0 ? x0 : x1;
        const uint4 pf = make_uint4(pk2(xx[8 * s2], xx[8 * s2 + 1]), pk2(xx[8 * s2 + 2], xx[8 * s2 + 3]), pk2(xx[8 * s2 + 4], xx[8 * s2 + 5]), pk2(xx[8 * s2 + 6], xx[8 * s2 + 7]));
        const int slot = 8 * st + 4 * s2 + hh;
        const char* vp = Vs + v * 128 + (slot & 1) * 8;
        const uint2 lo = *(const uint2*)(vp + (((slot >> 1) ^ (v & 7)) << 4)), hi = *(const uint2*)(vp + ((((slot >> 1) + 1) ^ (v & 7)) << 4));
        o[vt] = MFMA(as_frag(make_uint4(lo.x, lo.y, hi.x, hi.y)), as_frag(pf), o[vt]);
      }
#pragma unroll
    for (int ks = 0; ks < 4; ++ks) o[vt] = MFMA(*(const bf16x8*)(Ss + v * 128 + (((2 * ks + hh) ^ ((v >> 1) & 7)) << 4)), qf[ks], o[vt]);
  }
  float sq = 0.f;
#pragma unroll
  for (int vt = 0; vt < 2; ++vt)
#pragma unroll
    for (int g = 0; g < 16; ++g) sq += o[vt][g] * o[vt][g];
  sq += __shfl_xor(sq, 32);
  if (hh == 0) part[vh * 64 + t] = sq;
  __syncthreads();
  const float rs = rsqrtf((part[t] + part[64 + t]) * (1.f / 128) + 1e-6f);
  const float* gng = p.gla_norm_g + l * 128;
#pragma unroll
  for (int vt = 0; vt < 2; ++vt)
#pragma unroll
    for (int g4 = 0; g4 < 4; ++g4) {
      const int v0 = (2 * vh + vt) * 32 + 8 * g4 + 4 * hh;
      const uint2 gv = *(const uint2*)(Gs + t * 256 + v0 * 2);
      const float4 gn = *(const float4*)(gng + v0);
      const float o0 = o[vt][4 * g4] * rs * gn.x * bflo(gv.x), o1 = o[vt][4 * g4 + 1] * rs * gn.y * bfhi(gv.x);
      const float o2 = o[vt][4 * g4 + 2] * rs * gn.z * bflo(gv.y), o3 = o[vt][4 * g4 + 3] * rs * gn.w * bfhi(gv.y);
      *(uint2*)(Os + t * 256 + v0 * 2) = make_uint2(pk2(o0, o1), pk2(o2, o3));
    }
  __syncthreads();
#pragma unroll
  for (int i = 0; i < 4; ++i) {
    const int idx = i * 256 + tid, row = idx >> 4, g16 = idx & 15;
    *(uint4*)(mix + (size_t)(c * 64 + row) * DM + 512 + h * 128 + g16 * 8) = *(const uint4*)(Os + idx * 16);
  }
  __syncthreads();
}

DI void gla_sample_item(const Params& p, int l, int item, char* lds) {
  const int tid = otid();
  const int b = item >> 2, h = item & 3;
  float* bS = (float*)lds;
  float* qtS = bS + 1024;
  float* ktS = qtS + 1024;
  float* keS = ktS + 1024;
  float* vS = keS + 1024;
  float* attS = vS + 2048;
  float* oS = attS + 256;
  const int row0 = TP + b * 16;
  const float* ab = (const float*)(p.ws + W_AB);
  const float* S0 = p.state_gla + ((size_t)(l * 32 + b) * 4 + h) * 8192;
  float s0v[64];
#pragma unroll
  for (int k = 0; k < 64; ++k) s0v[k] = S0[k * 128 + (tid & 127)];
  if (tid < 64) {
    const int k = tid;
    float wg[16];
#pragma unroll
    for (int j = 0; j < 16; ++j) wg[j] = p.w_gate_up[((size_t)l * 16 + j) * 256 + h * 64 + k];
    const float bias = p.b_gate[l * 256 + h * 64 + k];
    float cum = 0.f;
    for (int t = 0; t < 16; ++t) {
      const float* a = ab + (size_t)(row0 + t) * 16;
      float z = bias;
#pragma unroll
      for (int j = 0; j < 16; ++j) z += a[j] * wg[j];
      cum += logsigmoidf_(z) * (1.f / 16);
      bS[t * 64 + k] = cum;
    }
  }
  __syncthreads();
  const u16* qb = (const u16*)(p.ws + W_QB); const u16* kb = (const u16*)(p.ws + W_KB); const u16* vbs = (const u16*)(p.ws + W_VBS);
  for (int i = 0; i < 4; ++i) {
    const int idx = tid + 256 * i, t = idx >> 6, k = idx & 63;
    const float qv = bf2f(qb[(size_t)(row0 + t) * 256 + h * 64 + k]), kv = bf2f(kb[(size_t)(row0 + t) * 256 + h * 64 + k]);
    const float bb = bS[t * 64 + k], bl = bS[15 * 64 + k];
    qtS[idx] = qv * __expf(bb); ktS[idx] = kv * __expf(-bb); keS[idx] = kv * __expf(bl - bb);
  }
  for (int i = 0; i < 8; ++i) {
    const int idx = tid + 256 * i, t = idx >> 7, v = idx & 127;
    vS[idx] = bf2f(vbs[(size_t)(b * 16 + t) * 512 + h * 128 + v]);
  }
  __syncthreads();
  {
    const int t = tid >> 4, s = tid & 15;
    float a = 0.f;
    if (s <= t) for (int k = 0; k < 64; ++k) a += qtS[t * 64 + k] * ktS[s * 64 + k];
    attS[tid] = a;
  }
  __syncthreads();
  {
    const int v = tid & 127, tg = tid >> 7;
    float acc[8];
#pragma unroll
    for (int i = 0; i < 8; ++i) {
      const int t = tg * 8 + i; float a = 0.f;
      for (int s = 0; s < 16; ++s) a += attS[t * 16 + s] * vS[s * 128 + v];
      acc[i] = a;
    }
#pragma unroll
    for (int k = 0; k < 64; ++k) {
      const float s0 = s0v[k];
#pragma unroll
      for (int i = 0; i < 8; ++i) acc[i] += qtS[(tg * 8 + i) * 64 + k] * s0;
    }
#pragma unroll
    for (int i = 0; i < 8; ++i) oS[(tg * 8 + i) * 128 + v] = acc[i];
    float* So = p.out + O_SS + ((size_t)(l * 32 + b) * 4 + h) * 8192;
#pragma unroll
    for (int kk = 0; kk < 32; ++kk) {
      const int k = tg * 32 + kk;
      float a = __expf(bS[15 * 64 + k]) * (tg == 0 ? s0v[kk] : s0v[32 + kk]);
#pragma unroll
      for (int t = 0; t < 16; ++t) a += keS[t * 64 + k] * vS[t * 128 + v];
      So[k * 128 + v] = a;
    }
  }
  __syncthreads();
  {
    const int t = tid >> 4, pt = tid & 15;
    float ov[8]; float sq = 0.f;
#pragma unroll
    for (int j = 0; j < 8; ++j) { ov[j] = oS[t * 128 + pt * 8 + j]; sq += ov[j] * ov[j]; }
    sq += __shfl_xor(sq, 1); sq += __shfl_xor(sq, 2); sq += __shfl_xor(sq, 4); sq += __shfl_xor(sq, 8);
    const float rs = rsqrtf(sq * (1.f / 128) + 1e-6f);
    const size_t off = (size_t)(row0 + t) * DM + 512 + h * 128 + pt * 8;
    float gv[8]; unpk8(*(const uint4*)((const u16*)(p.ws + W_GATE) + off), gv);
    const float* gng = p.gla_norm_g + l * 128 + pt * 8;
#pragma unroll
    for (int j = 0; j < 8; ++j) ov[j] = ov[j] * rs * gng[j] * gv[j];
    *(uint4*)((u16*)(p.ws + W_MIX) + off) = pk8(ov);
  }
  __syncthreads();
}

DI void phaseS(const Params& p, int l, char* lds) {
  if (vgrid() == 512) {
    const int hb = vbid();
    if (hb < 128) { scan_item(p, l, hb); attn_prompt_item(p, l, hb, lds); attn_prompt_item(p, l, 128 + hb, lds); attn_prompt_item(p, l, 256 + hb, lds); }
    else if (hb < 256) { gla_sample_item(p, l, hb - 128, lds); attn_prompt_item(p, l, 384 + hb - 128, lds); }
    else { attn_sample_item(p, l, hb - 256, lds); attn_prompt_item(p, l, 512 + hb - 256, lds); attn_prompt_item(p, l, 768 + hb - 256, lds); }
    return;
  }
  for (int it = vbid(); it < 512 + 1024; it += vgrid()) {
    if (it < 128) scan_item(p, l, it);
    else if (it < 256) gla_sample_item(p, l, it - 128, lds);
    else if (it < 512) attn_sample_item(p, l, it - 256, lds);
    else attn_prompt_item(p, l, it - 512, lds);
  }
}

DI void phaseO(const Params& p, int l, char* lds) {
  for (int it = vbid(); it < NCH * 4; it += vgrid()) gla_out_prompt(p, l, it, lds);
  {
    const int tid = otid();
    const float* src = p.p_prompt + (size_t)l * TP * DPLE;
    u16* dst = (u16*)(p.ws + W_PB);
    const int per = (TP * DPLE / 8 + vgrid() * NTHR - 1) / (vgrid() * NTHR);
    for (int j = 0; j < per; ++j) {
      const size_t i = ((size_t)j * vgrid() + vbid()) * NTHR + tid;
      if (i < (size_t)TP * DPLE / 8) {
        const float4 f0 = *(const float4*)(src + i * 8), f1 = *(const float4*)(src + i * 8 + 4);
        *(uint4*)(dst + i * 8) = make_uint4(pk2(f0.x, f0.y), pk2(f0.z, f0.w), pk2(f1.x, f1.y), pk2(f1.z, f1.w));
      }
    }
  }
}

DI const float* hres_row(const Params& p, int l, int grow) {
  if (l == 0) return grow < TP ? p.x_prompt + (size_t)grow * DM : p.x_sample + (size_t)(grow - TP) * DM;
  return p.out + (size_t)grow * DM;
}
DI void phaseC(const Params& p, int l, char* lds, int vb) {
  const int tid = otid();
  float* C = (float*)lds;
  const u16* mix = (const u16*)(p.ws + W_MIX);
  const u16* wt = (const u16*)(p.ws + W_WOUT) + (size_t)l * DM * DM;
  u16* hb = (u16*)(p.ws + W_HB);
  const u16* wpe = (const u16*)(p.ws + W_WPE) + (size_t)l * DM * DPLE;
  u16* peb = (u16*)(p.ws + W_GATE);
  for (int rnd = 0;; ++rnd) {
    const int spos = seq_pos(rnd, vb);
    if (rnd * vgrid() >= MT * 16) break;
    if (spos >= MT * 16) continue;
    int mt, nn; pos_to_tile(spos, MT, 16, 4, mt, nn);
    nn = (nn + 8 * (rnd & 1)) & 15;
    const int tile = nn;
    const int nt = nn & 7, m0 = mt * 128, n0 = nt * 128;
    f32x16 acc[2][2];
    for (int i = 0; i < 2; ++i) for (int j = 0; j < 2; ++j) acc[i][j] = zero16();
    float ss[4] = {0.f, 0.f, 0.f, 0.f};
    if (tile & 8) {
      const float* pa = m0 < TP ? p.p_prompt + ((size_t)l * TP + m0) * DPLE : p.p_sample + ((size_t)l * TS + (m0 - TP)) * DPLE;
      gemm_main<true, false>(pa, DPLE, wpe + (size_t)n0 * DPLE, DPLE, DPLE, acc, lds, ss);
      acc_to_lds(acc, C);
      __syncthreads();
#pragma unroll 1
      for (int it = 0; it < 8; ++it) {
        const int item = it * 256 + tid, row = item >> 4, cgp = item & 15;
        const float4 a = *(const float4*)(C + row * 132 + cgp * 8), b = *(const float4*)(C + row * 132 + cgp * 8 + 4);
        const float v[8] = {a.x, a.y, a.z, a.w, b.x, b.y, b.z, b.w};
        *(uint4*)(peb + (size_t)(m0 + row) * DM + n0 + cgp * 8) = pk8(v);
      }
      __syncthreads();
      continue;
    }
    gemm_main<false, false>(mix + (size_t)m0 * DM, DM, wt + (size_t)n0 * DM, DM, DM, acc, lds, ss);
    acc_to_lds(acc, C);
    __syncthreads();
#pragma unroll 1
    for (int it = 0; it < 8; ++it) {
      const int item = it * 256 + tid, row = item >> 4, cgp = item & 15;
      const int grow = m0 + row;
      const float* hr = hres_row(p, l, grow) + n0 + cgp * 8;
      const float4 h0 = *(const float4*)hr, h1 = *(const float4*)(hr + 4);
      const float4 a = *(const float4*)(C + row * 132 + cgp * 8), b = *(const float4*)(C + row * 132 + cgp * 8 + 4);
      float v[8] = {h0.x + a.x, h0.y + a.y, h0.z + a.z, h0.w + a.w, h1.x + b.x, h1.y + b.y, h1.z + b.z, h1.w + b.w};
      float* d = p.out + (size_t)grow * DM + n0 + cgp * 8;
      *(float4*)d = make_float4(v[0], v[1], v[2], v[3]); *(float4*)(d + 4) = make_float4(v[4], v[5], v[6], v[7]);
      *(uint4*)(hb + (size_t)grow * DM + n0 + cgp * 8) = pk8(v);
      float sq = v[0] * v[0] + v[1] * v[1] + v[2] * v[2] + v[3] * v[3] + v[4] * v[4] + v[5] * v[5] + v[6] * v[6] + v[7] * v[7];
      sq += __shfl_xor(sq, 1); sq += __shfl_xor(sq, 2); sq += __shfl_xor(sq, 4); sq += __shfl_xor(sq, 8);
      if (cgp == 0) atomicAdd((float*)(p.ws + W_SSD) + grow, sq);
    }
    __syncthreads();
  }
}

DI void phaseD(const Params& p, int l, char* lds, int vb) {
  const int tid = otid();
  float* C = (float*)lds;
  float* rstd = (float*)(lds + 128 * 132 * 4);
  const u16* hb = (const u16*)(p.ws + W_HB);
  u16* hbn = (u16*)(p.ws + W_MIX);
  const u16* wpg = (const u16*)(p.ws + W_WPG) + (size_t)l * DM * DM;
  const u16* peb = (const u16*)(p.ws + W_GATE);
  for (int rnd = 0;; ++rnd) {
    const int spos = seq_pos(rnd, vb);
    if (rnd * vgrid() >= MT * 8) break;
    if (spos >= MT * 8) continue;
    int mt, nt; pos_to_tile(spos, MT, 8, 8, mt, nt);
    const int m0 = mt * 128, n0 = nt * 128;
    f32x16 acc[2][2];
    for (int i = 0; i < 2; ++i) for (int j = 0; j < 2; ++j) acc[i][j] = zero16();
    float ss[4] = {0.f, 0.f, 0.f, 0.f};
    gemm_main<false, false>(hb + (size_t)m0 * DM, DM, wpg + (size_t)n0 * DM, DM, DM, acc, lds, ss);
    acc_to_lds(acc, C);
    if (tid < 128) rstd[tid] = rsqrtf(((const float*)(p.ws + W_SSD))[m0 + tid] * (1.f / DM) + 1e-6f);
    __syncthreads();
#pragma unroll 1
    for (int it = 0; it < 8; ++it) {
      const int item = it * 256 + tid, row = item >> 4, cgp = item & 15;
      const int grow = m0 + row;
      const float rs = rstd[row];
      float* d = p.out + (size_t)grow * DM + n0 + cgp * 8;
      const float4 h0 = *(const float4*)d, h1 = *(const float4*)(d + 4);
      float pv[8]; unpk8(*(const uint4*)(peb + (size_t)grow * DM + n0 + cgp * 8), pv);
      const float4 a = *(const float4*)(C + row * 132 + cgp * 8), b = *(const float4*)(C + row * 132 + cgp * 8 + 4);
      float v[8] = {h0.x + sigmoidf_(a.x * rs) * pv[0], h0.y + sigmoidf_(a.y * rs) * pv[1], h0.z + sigmoidf_(a.z * rs) * pv[2], h0.w + sigmoidf_(a.w * rs) * pv[3],
                    h1.x + sigmoidf_(b.x * rs) * pv[4], h1.y + sigmoidf_(b.y * rs) * pv[5], h1.z + sigmoidf_(b.z * rs) * pv[6], h1.w + sigmoidf_(b.w * rs) * pv[7]};
      *(float4*)d = make_float4(v[0], v[1], v[2], v[3]); *(float4*)(d + 4) = make_float4(v[4], v[5], v[6], v[7]);
      *(uint4*)(hbn + (size_t)grow * DM + n0 + cgp * 8) = pk8(v);
      float sq = v[0] * v[0] + v[1] * v[1] + v[2] * v[2] + v[3] * v[3] + v[4] * v[4] + v[5] * v[5] + v[6] * v[6] + v[7] * v[7];
      sq += __shfl_xor(sq, 1); sq += __shfl_xor(sq, 2); sq += __shfl_xor(sq, 4); sq += __shfl_xor(sq, 8);
      if (cgp == 0) atomicAdd((float*)(p.ws + W_SSA) + grow, sq);
    }
    __syncthreads();
  }
}

struct EpiC {
  const float* hres; float* out; u16* hb; float* ss;
  DI void operator()(const pg8::f32x4 (&acc)[2][2][4][2], const pg8::Unit& u, int wr, int wc, int fr, int fq) const {
    const int cb = u.pn * 256 + wc * 64 + 8 * fq;
#pragma unroll
    for (int ai = 0; ai < 2; ++ai)
#pragma unroll
      for (int m = 0; m < 4; ++m) {
        const int row = u.pm * 256 + ai * 128 + wr * 64 + m * 16 + fr;
        float sq = 0.f;
#pragma unroll
        for (int bj = 0; bj < 2; ++bj) {
          const size_t o = (size_t)row * DM + cb + 32 * bj;
          const float4 h0 = *(const float4*)(hres + o), h1 = *(const float4*)(hres + o + 4);
          float v[8] = {h0.x + acc[ai][bj][m][0][0], h0.y + acc[ai][bj][m][0][1], h0.z + acc[ai][bj][m][0][2], h0.w + acc[ai][bj][m][0][3],
                        h1.x + acc[ai][bj][m][1][0], h1.y + acc[ai][bj][m][1][1], h1.z + acc[ai][bj][m][1][2], h1.w + acc[ai][bj][m][1][3]};
          *(float4*)(out + o) = make_float4(v[0], v[1], v[2], v[3]); *(float4*)(out + o + 4) = make_float4(v[4], v[5], v[6], v[7]);
          *(uint4*)(hb + o) = pk8(v);
#pragma unroll
          for (int e = 0; e < 8; ++e) sq += v[e] * v[e];
        }
        sq += __shfl_xor(sq, 16); sq += __shfl_xor(sq, 32);
        if (fq == 0) atomicAdd(ss + row, sq);
        if (m & 1) asm volatile("" ::: "memory");
      }
  }
};
struct EpiPe {
  u16* peb;
  DI void operator()(const pg8::f32x4 (&acc)[2][2][4][2], const pg8::Unit& u, int wr, int wc, int fr, int fq) const {
    const int cb = u.pn * 256 + wc * 64 + 8 * fq;
#pragma unroll
    for (int ai = 0; ai < 2; ++ai)
#pragma unroll
      for (int m = 0; m < 4; ++m) {
        const int row = u.pm * 256 + ai * 128 + wr * 64 + m * 16 + fr;
#pragma unroll
        for (int bj = 0; bj < 2; ++bj) {
          const float v[8] = {acc[ai][bj][m][0][0], acc[ai][bj][m][0][1], acc[ai][bj][m][0][2], acc[ai][bj][m][0][3], acc[ai][bj][m][1][0], acc[ai][bj][m][1][1], acc[ai][bj][m][1][2], acc[ai][bj][m][1][3]};
          *(uint4*)(peb + (size_t)row * DM + cb + 32 * bj) = pk8(v);
        }
      }
  }
};
struct EpiD {
  float* out; const u16* peb; u16* hbn; const float* ssd; float* ssa;
  DI void operator()(const pg8::f32x4 (&acc)[2][2][4][2], const pg8::Unit& u, int wr, int wc, int fr, int fq) const {
    const int cb = u.pn * 256 + wc * 64 + 8 * fq;
    float rsv[8];
#pragma unroll
    for (int i = 0; i < 8; ++i) rsv[i] = ssd[u.pm * 256 + (i >> 2) * 128 + wr * 64 + (i & 3) * 16 + fr];
#pragma unroll
    for (int i = 0; i < 8; ++i) rsv[i] = rsqrtf(rsv[i] * (1.f / DM) + 1e-6f);
#pragma unroll
    for (int ai = 0; ai < 2; ++ai)
#pragma unroll
      for (int m = 0; m < 4; ++m) {
        const int row = u.pm * 256 + ai * 128 + wr * 64 + m * 16 + fr;
        const float rs = rsv[ai * 4 + m];
        float sq = 0.f;
#pragma unroll
        for (int bj = 0; bj < 2; ++bj) {
          const size_t o = (size_t)row * DM + cb + 32 * bj;
          const float4 h0 = *(const float4*)(out + o), h1 = *(const float4*)(out + o + 4);
          float pv[8]; unpk8(*(const uint4*)(peb + o), pv);
          float v[8] = {h0.x + sigmoidf_(acc[ai][bj][m][0][0] * rs) * pv[0], h0.y + sigmoidf_(acc[ai][bj][m][0][1] * rs) * pv[1], h0.z + sigmoidf_(acc[ai][bj][m][0][2] * rs) * pv[2], h0.w + sigmoidf_(acc[ai][bj][m][0][3] * rs) * pv[3],
                        h1.x + sigmoidf_(acc[ai][bj][m][1][0] * rs) * pv[4], h1.y + sigmoidf_(acc[ai][bj][m][1][1] * rs) * pv[5], h1.z + sigmoidf_(acc[ai][bj][m][1][2] * rs) * pv[6], h1.w + sigmoidf_(acc[ai][bj][m][1][3] * rs) * pv[7]};
          *(float4*)(out + o) = make_float4(v[0], v[1], v[2], v[3]); *(float4*)(out + o + 4) = make_float4(v[4], v[5], v[6], v[7]);
          *(uint4*)(hbn + o) = pk8(v);
#pragma unroll
          for (int e = 0; e < 8; ++e) sq += v[e] * v[e];
        }
        sq += __shfl_xor(sq, 16); sq += __shfl_xor(sq, 32);
        if (fq == 0) atomicAdd(ssa + row, sq);
        if (m & 1) asm volatile("" ::: "memory");
      }
  }
};

template <bool AF32, int K>
DI void mini_gemm(const void* __restrict__ A, int lda, const u16* __restrict__ Bt, int ldb, int r0, int c0, float* red, float (&o)[4]) {
  const int tid = otid(), lane = tid & 63, w = tid >> 6, r = lane & 31, hh = lane >> 5;
  char* As = (char*)red;
  constexpr int KH = K < 512 ? K : 512;
  constexpr int CPR = KH >> 3;
  constexpr int NP = 32 * CPR / 256;
  char* Bs = As + 32 * KH * 2;
  f32x16 acc = zero16();
  for (int kh = 0; kh < K; kh += KH) {
    uint4 ar[NP], br[NP];
#pragma unroll
    for (int i = 0; i < NP; ++i) {
      const int idx = i * 256 + tid;
      {
        const int row = idx / CPR, ch = idx - row * CPR;
        if (AF32) {
          const float* ap = (const float*)A + (size_t)(r0 + row) * lda + kh + ch * 8;
          const float4 f0 = *(const float4*)ap, f1 = *(const float4*)(ap + 4);
          ar[i] = make_uint4(pk2(f0.x, f0.y), pk2(f0.z, f0.w), pk2(f1.x, f1.y), pk2(f1.z, f1.w));
        } else {
          ar[i] = *(const uint4*)((const u16*)A + (size_t)(r0 + row) * lda + kh + ch * 8);
        }
        br[i] = *(const uint4*)(Bt + (size_t)(c0 + row) * ldb + kh + ch * 8);
      }
    }
#pragma unroll
    for (int i = 0; i < NP; ++i) {
      const int idx = i * 256 + tid;
      {
        const int row = idx / CPR, ch = idx - row * CPR;
        const int off = row * KH * 2 + (((ch & ~15) | ((ch ^ row) & 15)) << 4);
        *(uint4*)(As + off) = ar[i]; *(uint4*)(Bs + off) = br[i];
      }
    }
    __syncthreads();
    const int cw = w * (CPR >> 2);
#pragma unroll
    for (int ks = 0; ks < (KH >> 6); ++ks) {
      const int ch = cw + 2 * ks + hh;
      const int off = r * KH * 2 + (((ch & ~15) | ((ch ^ r) & 15)) << 4);
      acc = MFMA(*(const bf16x8*)(As + off), *(const bf16x8*)(Bs + off), acc);
    }
    __syncthreads();
  }
#pragma unroll
  for (int g = 0; g < 16; ++g) red[w * 1056 + crow(g, hh) * 33 + r] = acc[g];
  __syncthreads();
  const int pr = tid >> 3, pc = (tid & 7) * 4;
#pragma unroll
  for (int i = 0; i < 4; ++i) o[i] = red[pr * 33 + pc + i] + red[1056 + pr * 33 + pc + i] + red[2112 + pr * 33 + pc + i] + red[3168 + pr * 33 + pc + i];
  __syncthreads();
}

DI void phaseC8(const Params& p, int l, char* lds_all, char* lds) {
  const u16* mix = (const u16*)(p.ws + W_MIX);
  const u16* wout = (const u16*)(p.ws + W_WOUT) + (size_t)l * DM * DM;
  const u16* wpe = (const u16*)(p.ws + W_WPE) + (size_t)l * DM * DPLE;
  u16* hb = (u16*)(p.ws + W_HB);
  u16* peb = (u16*)(p.ws + W_GATE);
  float* ssD = (float*)(p.ws + W_SSD);
  {
    pg8::Gemm g{mix, wout, TP, DM, DM};
    pg8::StaticOrder S; S.init(TP, DM, (int)gridDim.x, obid());
    EpiC E{l == 0 ? p.x_prompt : p.out, p.out, hb, ssD};
    pg8::gemm_phase<EpiC>((LAS unsigned char*)lds_all, g, S, E);
  }
  {
    pg8::Gemm g{(const u16*)(p.ws + W_PB), wpe, TP, DM, DPLE};
    pg8::StaticOrder S; S.init(TP, DM, (int)gridDim.x, obid());
    EpiPe E{peb};
    pg8::gemm_phase<EpiPe>((LAS unsigned char*)lds_all, g, S, E);
  }
  const int tid = otid();
  for (int mt = vbid(); mt < 512; mt += vgrid()) {
    const int r0 = TP + (mt >> 5) * 32, c0 = (mt & 31) * 32;
    const int row = r0 + (tid >> 3), col = c0 + (tid & 7) * 4;
    float o[4];
    mini_gemm<false, DM>(mix, DM, wout, DM, r0, c0, (float*)lds, o);
    {
      const size_t off = (size_t)row * DM + col;
      const float4 h = *(const float4*)(l == 0 ? p.x_sample + (size_t)(row - TP) * DM + col : p.out + off);
      const float v0 = h.x + o[0], v1 = h.y + o[1], v2 = h.z + o[2], v3 = h.w + o[3];
      *(float4*)(p.out + off) = make_float4(v0, v1, v2, v3);
      *(uint2*)(hb + off) = make_uint2(pk2(v0, v1), pk2(v2, v3));
      float sq = v0 * v0 + v1 * v1 + v2 * v2 + v3 * v3;
      sq += __shfl_xor(sq, 1); sq += __shfl_xor(sq, 2); sq += __shfl_xor(sq, 4);
      if ((tid & 7) == 0) atomicAdd(ssD + row, sq);
    }
    mini_gemm<true, DPLE>(p.p_sample + (size_t)l * TS * DPLE, DPLE, wpe, DPLE, r0 - TP, c0, (float*)lds, o);
    *(uint2*)(peb + (size_t)row * DM + col) = make_uint2(pk2(o[0], o[1]), pk2(o[2], o[3]));
  }
}

DI void phaseD8(const Params& p, int l, char* lds_all, char* lds) {
  const u16* hb = (const u16*)(p.ws + W_HB);
  const u16* wpg = (const u16*)(p.ws + W_WPG) + (size_t)l * DM * DM;
  const u16* peb = (const u16*)(p.ws + W_GATE);
  u16* hbn = (u16*)(p.ws + W_MIX);
  const float* ssD = (const float*)(p.ws + W_SSD);
  float* ssA = (float*)(p.ws + W_SSA);
  {
    pg8::Gemm g{hb, wpg, TP, DM, DM};
    pg8::StaticOrder S; S.init(TP, DM, (int)gridDim.x, obid());
    EpiD E{p.out, peb, hbn, ssD, ssA};
    pg8::gemm_phase<EpiD>((LAS unsigned char*)lds_all, g, S, E);
  }
  const int tid = otid();
  for (int mt = vbid(); mt < 512; mt += vgrid()) {
    const int r0 = TP + (mt >> 5) * 32, c0 = (mt & 31) * 32;
    const int row = r0 + (tid >> 3), col = c0 + (tid & 7) * 4;
    float o[4];
    mini_gemm<false, DM>(hb, DM, wpg, DM, r0, c0, (float*)lds, o);
    const size_t off = (size_t)row * DM + col;
    const float rs = rsqrtf(ssD[row] * (1.f / DM) + 1e-6f);
    const float4 h = *(const float4*)(p.out + off);
    const uint2 pe = *(const uint2*)(peb + off);
    const float v0 = h.x + sigmoidf_(o[0] * rs) * bflo(pe.x), v1 = h.y + sigmoidf_(o[1] * rs) * bfhi(pe.x), v2 = h.z + sigmoidf_(o[2] * rs) * bflo(pe.y), v3 = h.w + sigmoidf_(o[3] * rs) * bfhi(pe.y);
    *(float4*)(p.out + off) = make_float4(v0, v1, v2, v3);
    *(uint2*)(hbn + off) = make_uint2(pk2(v0, v1), pk2(v2, v3));
    float sq = v0 * v0 + v1 * v1 + v2 * v2 + v3 * v3;
    sq += __shfl_xor(sq, 1); sq += __shfl_xor(sq, 2); sq += __shfl_xor(sq, 4);
    if ((tid & 7) == 0) atomicAdd(ssA + row, sq);
  }
}

__global__ void __launch_bounds__(NBLK_THREADS, 2) hymba_fwd(Params p) {
  extern __shared__ __attribute__((aligned(16))) char lds_all[];
  cg::grid_group grid = cg::this_grid();
  char* lds = lds_all + hhalf() * LDS_HALF;
  if (threadIdx.x == 0) *(uint4*)(lds_all + LDS_MAIN) = make_uint4(0u, 0u, 0u, 0u);
  __syncthreads();
  XcdBarrier bar = xcd_barrier_post((unsigned*)(p.ws + W_BAR), (volatile LAS unsigned*)(lds_all + LDS_MAIN));
  phase0(p, lds);
  grid.sync();
  for (int l = 0; l < DEPTH; ++l) {
    phaseA8(p, l, lds_all);
    xcd_barrier(bar);
    phaseB(p, l, lds);
    xcd_barrier(bar);
    phaseS(p, l, lds);
    xcd_barrier(bar);
    phaseO(p, l, lds);
    xcd_barrier(bar);
    phaseC8(p, l, lds_all, lds);
    xcd_barrier(bar);
    phaseD8(p, l, lds_all, lds);
    if (l + 1 < DEPTH) xcd_barrier(bar);
  }
}

extern "C" void kernel_launch(void* const* d_in, const int* in_sizes, int n_in, void* d_out, int out_size, void* d_ws, size_t ws_size, hipStream_t stream) {
  static int grid_blocks = 0;
  if (!grid_blocks) {
    int dev = 0, cus = 0, per_cu = 0;
    (void)hipGetDevice(&dev);
    (void)hipDeviceGetAttribute(&cus, hipDeviceAttributeMultiprocessorCount, dev);
    if (hipFuncSetAttribute((const void*)hymba_fwd, hipFuncAttributeMaxDynamicSharedMemorySize, LDS_BYTES) != hipSuccess) fprintf(stderr, "kernel_launch: hipFuncSetAttribute(%d B dynamic LDS) failed\n", LDS_BYTES);
    (void)hipOccupancyMaxActiveBlocksPerMultiprocessor(&per_cu, hymba_fwd, NBLK_THREADS, LDS_BYTES);
    if (per_cu > 1) per_cu = 1;
    if (per_cu < 1) { fprintf(stderr, "kernel_launch: occupancy query reports %d blocks per CU\n", per_cu); per_cu = 1; }
    grid_blocks = cus * per_cu;
    if (ws_size < W_END) fprintf(stderr, "kernel_launch: workspace too small: %zu < %zu\n", ws_size, (size_t)W_END);
  }
  Params p{};
  const float** f = (const float**)&p;
  for (int i = 0; i < 19; ++i) f[i] = (const float*)d_in[i];
  p.out = (float*)d_out;
  p.ws = (char*)d_ws;
  (void)hipMemsetAsync((char*)d_ws + W_BAR, 0, XCD_BAR_WORDS * 4, stream);
  void* args[] = {&p};
  hipError_t e = hipLaunchCooperativeKernel((void*)hymba_fwd, dim3(grid_blocks), dim3(NBLK_THREADS), args, LDS_BYTES, stream);
  if (e != hipSuccess) fprintf(stderr, "cooperative launch failed: %s (grid %d)\n", hipGetErrorString(e), grid_blocks);
}
```

```cpp
#include <hip/hip_runtime.h>
#include <hip/hip_cooperative_groups.h>
#include <cstdio>
namespace cg = cooperative_groups;

#define DI __device__ __forceinline__
typedef __attribute__((ext_vector_type(8))) short bf16x8;
typedef __attribute__((ext_vector_type(16))) float f32x16;
typedef __attribute__((ext_vector_type(2))) __bf16 bf2_t;
typedef unsigned short u16;

constexpr int TP = 16384, TS = 512, TT = TP + TS;
constexpr int DM = 1024, DEPTH = 4, DPLE = 256;
constexpr int NIN = 2832, NINP = 2944;
constexpr int NTHR = 256;
constexpr int MT = TT / 128;
constexpr int NCH = TP / 64;
constexpr int TPS = TP + 192;
constexpr int XCD_BAR_WORDS_C = 4032;

constexpr size_t O_Y = 0;
constexpr size_t O_KP = (size_t)TT * DM;
constexpr size_t O_VP = O_KP + 4 * 16384;
constexpr size_t O_SP = O_VP + 4 * 16384;
constexpr size_t O_KS = O_SP + 4 * 32768;
constexpr size_t O_VS = O_KS + 4 * 65536;
constexpr size_t O_SS = O_VS + 4 * 65536;

constexpr size_t W_WIN = 0;
constexpr size_t W_WOUT = W_WIN + (size_t)DEPTH * NINP * DM * 2;
constexpr size_t W_WPG = W_WOUT + (size_t)DEPTH * DM * DM * 2;
constexpr size_t W_WPE = W_WPG + (size_t)DEPTH * DM * DM * 2;
constexpr size_t W_HB = W_WPE + (size_t)DEPTH * DM * DPLE * 2;
constexpr size_t W_Q = W_HB + (size_t)TT * DM * 2;
constexpr size_t W_K = W_Q + (size_t)TT * 512 * 2;
constexpr size_t W_VT = W_K + (size_t)TT * 128 * 2;
constexpr size_t W_GATE = W_VT + (size_t)128 * TPS * 2;
constexpr size_t W_QB = W_GATE + (size_t)TT * DM * 2;
constexpr size_t W_KB = W_QB + (size_t)TT * 256 * 2;
constexpr size_t W_KBT = W_KB + (size_t)TT * 256 * 2;
constexpr size_t W_VBS = W_KBT + (size_t)256 * TPS * 2;
constexpr size_t W_VBT = W_VBS + (size_t)TS * 512 * 2;
constexpr size_t W_AB = W_VBT + (size_t)512 * TPS * 2;
constexpr size_t W_MIX = W_AB + (size_t)TT * 16 * 4;
constexpr size_t W_S = W_MIX + (size_t)TT * DM * 2;
constexpr size_t W_DEC = W_S + (size_t)NCH * 32768 * 4;
constexpr size_t W_ROPE = W_DEC + (size_t)NCH * 256 * 4;
constexpr size_t W_SSA = W_ROPE + (size_t)TP * 16 * 4;
constexpr size_t W_SSD = W_SSA + (size_t)TT * 4;
constexpr size_t W_PB = W_SSD + (size_t)TT * 4;
constexpr size_t W_BAR = W_PB + (size_t)TP * DPLE * 2;
constexpr size_t W_END = W_BAR + XCD_BAR_WORDS_C * 4;

constexpr int LDS_HALF = 128 * 132 * 4 + 512;
constexpr int LDS_MAIN = 2 * LDS_HALF;
constexpr int LDS_BYTES = LDS_MAIN + 16;
constexpr int NBLK_THREADS = 512;

struct Params {
  const float *x_prompt, *x_sample, *cache_k, *cache_v, *state_gla, *p_prompt, *p_sample, *norm_g, *w_in, *q_norm_g, *k_norm_g,
      *sinks, *w_gate_up, *b_gate, *gla_norm_g, *w_out, *pe_norm_g, *w_pe, *w_pg;
  float* out;
  char* ws;
};

DI unsigned pk2(float a, float b) { bf2_t v; v[0] = (__bf16)a; v[1] = (__bf16)b; return __builtin_bit_cast(unsigned, v); }
DI float bflo(unsigned u) { return __uint_as_float(u << 16); }
DI float bfhi(unsigned u) { return __uint_as_float(u & 0xffff0000u); }
DI float bf2f(u16 u) { return __uint_as_float(((unsigned)u) << 16); }
DI uint4 pk8(const float* v) { return make_uint4(pk2(v[0], v[1]), pk2(v[2], v[3]), pk2(v[4], v[5]), pk2(v[6], v[7])); }
DI void unpk8(uint4 u, float* v) {
  v[0] = bflo(u.x); v[1] = bfhi(u.x); v[2] = bflo(u.y); v[3] = bfhi(u.y);
  v[4] = bflo(u.z); v[5] = bfhi(u.z); v[6] = bflo(u.w); v[7] = bfhi(u.w);
}
DI int otid() { int t = threadIdx.x & 255; asm volatile("" : "+v"(t)); return t; }
DI int hhalf() { return __builtin_amdgcn_readfirstlane((int)(threadIdx.x >> 8)); }
DI int vbid() { return (int)blockIdx.x * 2 + hhalf(); }
DI int obid() { int b = blockIdx.x; asm volatile("" : "+s"(b)); return b; }
DI int vgrid() { return (int)gridDim.x * 2; }
DI size_t tidx(int NR, int col, int token) { return ((size_t)(token >> 6) * NR + col) * 64 + (token & 63); }
DI int crow(int reg, int h) { return (reg & 3) + 8 * (reg >> 2) + 4 * h; }
#define MFMA(a, b, c) __builtin_amdgcn_mfma_f32_32x32x16_bf16((a), (b), (c), 0, 0, 0)
DI bf16x8 as_frag(uint4 u) { return __builtin_bit_cast(bf16x8, u); }
DI f32x16 zero16() { f32x16 z; for (int i = 0; i < 16; ++i) z[i] = 0.f; return z; }
DI float sigmoidf_(float x) { return __builtin_amdgcn_rcpf(1.f + __expf(-x)); }
DI float siluf_(float x) { return x * __builtin_amdgcn_rcpf(1.f + __expf(-x)); }
DI float logsigmoidf_(float z) { return fminf(z, 0.f) - __logf(1.f + __expf(-fabsf(z))); }


#define XB_TMO      128
#define XB_XCNT(j)  (256  + 64 * (j))
#define XB_XSUB(j)  (1280 + 64 * (j))
#define XB_XGEN(j)  (2304 + 64 * (j))
#define XB_TOP      3328
#define XB_TOPGEN   3392
#define XB_RANK(j)  (3456 + 64 * (j))
#define XCD_BAR_WORDS 4032
#define XB_SPIN_CAP (1u << 22)
#define LAS __attribute__((address_space(3)))
DI unsigned xb_ld(unsigned* p) { return __hip_atomic_load(p, __ATOMIC_RELAXED, __HIP_MEMORY_SCOPE_AGENT); }
DI unsigned xb_add(unsigned* p, unsigned v) { return __hip_atomic_fetch_add(p, v, __ATOMIC_RELAXED, __HIP_MEMORY_SCOPE_AGENT); }
DI unsigned xb_xcc_id() { return (unsigned)__builtin_amdgcn_s_getreg((3 << 11) | 20) & 0xFu; }
#define XB_SPIN(cond, bar) do { unsigned _sp = 0; while (cond) { __builtin_amdgcn_s_sleep(1); \
    if ((++_sp & 255u) == 0u) { if (xb_ld(&(bar)[XB_TMO])) break; if (_sp > XB_SPIN_CAP) { atomicAdd(&(bar)[XB_TMO], 1u); break; } } } } while (0)
struct XcdBarrier { unsigned* bar; unsigned x; volatile LAS unsigned* st; };
DI XcdBarrier xcd_barrier_post(unsigned* bar, volatile LAS unsigned* st) {
  XcdBarrier b; b.bar = bar; b.x = xb_xcc_id(); b.st = st;
  if (threadIdx.x == 0) (void)xb_add(&bar[XB_XCNT(b.x)], 1u);
  return b;
}
DI void xcd_barrier_complete(unsigned* bar, unsigned x, unsigned& nloc, unsigned& nx) {
  const unsigned G = gridDim.x * gridDim.y * gridDim.z;
  unsigned sum, cnt, mine, sp = 0u;
  for (;;) {
    sum = 0u; cnt = 0u; mine = 0u;
#pragma unroll
    for (unsigned j = 0; j < 16; ++j) { const unsigned c = xb_ld(&bar[XB_XCNT(j)]); sum += c; cnt += (c > 0u) ? 1u : 0u; mine = (j == x) ? c : mine; }
    if (sum == G) break;
    __builtin_amdgcn_s_sleep(1);
    if ((++sp & 255u) == 0u) { if (xb_ld(&bar[XB_TMO])) break; if (sp > XB_SPIN_CAP) { atomicAdd(&bar[XB_TMO], 1u); break; } }
  }
  nloc = mine > 0u ? mine : 1u; nx = cnt > 0u ? cnt : 1u;
}
DI void xcd_barrier(const XcdBarrier& b) {
  asm volatile("s_waitcnt vmcnt(0)" ::: "memory");
  __syncthreads();
  if (threadIdx.x == 0) {
    unsigned* bar = b.bar;
    __builtin_amdgcn_s_waitcnt(0);
    unsigned nloc = b.st[0], nx = b.st[1];
    if (nloc == 0u) { xcd_barrier_complete(bar, b.x, nloc, nx); b.st[0] = nloc; b.st[1] = nx; }
    const unsigned old = xb_add(&bar[XB_XSUB(b.x)], 1u);
    const unsigned gen = old / nloc;
    if (old + 1u == (gen + 1u) * nloc) {
      __builtin_amdgcn_fence(__ATOMIC_RELEASE, "agent");
      asm volatile("s_waitcnt vmcnt(0)" ::: "memory");
      const unsigned og = xb_add(&bar[XB_TOP], 1u);
      const unsigned tg = og / nx;
      if (og + 1u == (tg + 1u) * nx) xb_add(&bar[XB_TOPGEN], 1u);
      else XB_SPIN(xb_ld(&bar[XB_TOPGEN]) == tg, bar);
      __builtin_amdgcn_fence(__ATOMIC_ACQUIRE, "agent");
      xb_add(&bar[XB_XGEN(b.x)], 1u);
      asm volatile("s_waitcnt vmcnt(0)" ::: "memory");
    } else {
      XB_SPIN(xb_ld(&bar[XB_XGEN(b.x)]) == gen, bar);
      __builtin_amdgcn_fence(__ATOMIC_ACQUIRE, "agent");
      asm volatile("s_waitcnt vmcnt(0)" ::: "memory");
    }
  }
  __syncthreads();
}

struct GStage { uint4 a0, a1, a2, a3, b0, b1, b2, b3; };
template <bool AF32>
DI uint4 gl_a(const void* __restrict__ Ab, size_t off) {
  if (AF32) {
    const float* ap = (const float*)Ab + off;
    const float4 f0 = *(const float4*)ap, f1 = *(const float4*)(ap + 4);
    return make_uint4(pk2(f0.x, f0.y), pk2(f0.z, f0.w), pk2(f1.x, f1.y), pk2(f1.z, f1.w));
  }
  return *(const uint4*)((const u16*)Ab + off);
}
template <bool AF32>
DI void g_load(GStage& s, const void* __restrict__ Ab, int lda, const u16* __restrict__ Bb, int ldb, int kt, int sr, int sc) {
  const size_t ao = (size_t)sr * lda + kt * 64 + sc * 8, bo = (size_t)sr * ldb + kt * 64 + sc * 8;
  s.a0 = gl_a<AF32>(Ab, ao); s.a1 = gl_a<AF32>(Ab, ao + (size_t)32 * lda); s.a2 = gl_a<AF32>(Ab, ao + (size_t)64 * lda); s.a3 = gl_a<AF32>(Ab, ao + (size_t)96 * lda);
  s.b0 = *(const uint4*)(Bb + bo); s.b1 = *(const uint4*)(Bb + bo + (size_t)32 * ldb); s.b2 = *(const uint4*)(Bb + bo + (size_t)64 * ldb); s.b3 = *(const uint4*)(Bb + bo + (size_t)96 * ldb);
}
DI float sq8(uint4 u) { float v[8]; unpk8(u, v); float s = 0.f;
#pragma unroll
  for (int j = 0; j < 8; ++j) s += v[j] * v[j];
  return s; }
DI void l_store(const GStage& s, char* base, int sr, int sc) {
  char* a = base; char* b = base + 16384;
  const int sw = ((sc ^ ((sr >> 1) & 7)) << 4);
  const int o0 = sr * 128 + sw;
  *(uint4*)(a + o0) = s.a0; *(uint4*)(a + o0 + 4096) = s.a1; *(uint4*)(a + o0 + 8192) = s.a2; *(uint4*)(a + o0 + 12288) = s.a3;
  *(uint4*)(b + o0) = s.b0; *(uint4*)(b + o0 + 4096) = s.b1; *(uint4*)(b + o0 + 8192) = s.b2; *(uint4*)(b + o0 + 12288) = s.b3;
}
DI float sq8f(bf16x8 f) { const uint4 u = __builtin_bit_cast(uint4, f); return sq8(u); }
template <bool SUMSQ>
DI void mma_step(const char* a, f32x16 (&acc)[2][2], int wm, int wn, int r, int hh, float (&ss)[4]) {
  const char* b = a + 16384;
#pragma unroll
  for (int ks = 0; ks < 4; ++ks) {
    bf16x8 af[2], bfr[2];
#pragma unroll
    for (int i = 0; i < 2; ++i) {
      const int arow = wm * 64 + i * 32 + r;
      af[i] = *(const bf16x8*)(a + arow * 128 + (((2 * ks + hh) ^ ((arow >> 1) & 7)) << 4));
      const int brow = wn * 64 + i * 32 + r;
      bfr[i] = *(const bf16x8*)(b + brow * 128 + (((2 * ks + hh) ^ ((brow >> 1) & 7)) << 4));
    }
#pragma unroll
    for (int mi = 0; mi < 2; ++mi)
#pragma unroll
      for (int ni = 0; ni < 2; ++ni) acc[mi][ni] = MFMA(af[mi], bfr[ni], acc[mi][ni]);
    if (SUMSQ) { ss[0] += sq8f(af[0]); ss[1] += sq8f(af[1]); }
  }
}
template <bool AF32, bool SUMSQ>
DI void gemm_main(const void* __restrict__ Ab, int lda, const u16* __restrict__ Bb, int ldb, int K, f32x16 (&acc)[2][2], char* lds, float (&ss)[4]) {
  const int tid = otid(), lane = tid & 63, w = tid >> 6;
  const int wm = w >> 1, wn = w & 1, r = lane & 31, hh = lane >> 5;
  const int sc = tid & 7, sr = tid >> 3;
  GStage s0, s1;
  const int nk = K >> 6;
  g_load<AF32>(s0, Ab, lda, Bb, ldb, 0, sr, sc);
  g_load<AF32>(s1, Ab, lda, Bb, ldb, 1, sr, sc);
  l_store(s0, lds, sr, sc);
  __syncthreads();
  for (int kt = 0; kt < nk; kt += 2) {
    if (kt + 2 < nk) g_load<AF32>(s0, Ab, lda, Bb, ldb, kt + 2, sr, sc);
    __builtin_amdgcn_sched_barrier(0);
    mma_step<SUMSQ>(lds, acc, wm, wn, r, hh, ss);
    __builtin_amdgcn_sched_barrier(0);
    l_store(s1, lds + 32768, sr, sc);
    __syncthreads();
    if (kt + 3 < nk) g_load<AF32>(s1, Ab, lda, Bb, ldb, kt + 3, sr, sc);
    __builtin_amdgcn_sched_barrier(0);
    mma_step<SUMSQ>(lds + 32768, acc, wm, wn, r, hh, ss);
    __builtin_amdgcn_sched_barrier(0);
    if (kt + 2 < nk) l_store(s0, lds, sr, sc);
    __syncthreads();
  }
}

DI void acc_to_lds(const f32x16 (&acc)[2][2], float* C) {
  const int tid = otid(), lane = tid & 63, w = tid >> 6;
  const int wm = w >> 1, wn = w & 1, r = lane & 31, hh = lane >> 5;
#pragma unroll
  for (int mi = 0; mi < 2; ++mi)
#pragma unroll
    for (int ni = 0; ni < 2; ++ni)
#pragma unroll
      for (int g = 0; g < 16; ++g) C[(wm * 64 + mi * 32 + crow(g, hh)) * 132 + wn * 64 + ni * 32 + r] = acc[mi][ni][g];
}
DI void ss_to_rstd(const float (&ss)[4], float* rstd, float invK) {
  const int tid = otid(), lane = tid & 63, w = tid >> 6;
  const int wm = w >> 1, wn = w & 1, r = lane & 31, hh = lane >> 5;
#pragma unroll
  for (int i = 0; i < 2; ++i) {
    float s = ss[i];
    s += __shfl_xor(s, 32);
    if (wn == 0 && hh == 0) rstd[wm * 64 + i * 32 + r] = rsqrtf(s * invK + 1e-6f);
  }
}

DI int seq_pos(int round, int vb) {
  const int G = vgrid();
  if (G != 512) return round * G + vbid();
  return (round * 8 + (vb >> 6)) * 64 + (vb & 63);
}
DI void pos_to_tile(int s, int MTn, int NTn, int SH, int& mt, int& nt) {
  const int strip_sz = SH * NTn;
  const int strip = s / strip_sz; const int w = s - strip * strip_sz;
  const int hgt = min(SH, MTn - strip * SH);
  nt = w / hgt; mt = strip * SH + (w - nt * hgt);
}

DI void transpose_item(const float* __restrict__ src, int K, int N, const float* __restrict__ g, u16* __restrict__ dst, int k0, int n0, float* L) {
  const int tid = otid();
#pragma unroll
  for (int i = 0; i < 4; ++i) {
    const int kk = i * 16 + (tid >> 4), n4 = (tid & 15) * 4;
    float4 v = make_float4(0.f, 0.f, 0.f, 0.f);
    if (n0 + n4 < N) {
      typedef float f4v __attribute__((ext_vector_type(4)));
      const f4v t = __builtin_nontemporal_load((const f4v*)(src + (size_t)(k0 + kk) * N + n0 + n4));
      v = make_float4(t.x, t.y, t.z, t.w);
      if (g) { const float gg = g[k0 + kk]; v.x *= gg; v.y *= gg; v.z *= gg; v.w *= gg; }
    }
    L[kk * 65 + n4] = v.x; L[kk * 65 + n4 + 1] = v.y; L[kk * 65 + n4 + 2] = v.z; L[kk * 65 + n4 + 3] = v.w;
  }
  __syncthreads();
  {
    const int n = tid >> 2, kq = tid & 3;
    float v[16];
#pragma unroll
    for (int j = 0; j < 16; ++j) v[j] = L[(kq * 16 + j) * 65 + n];
    uint4* d = (uint4*)(dst + (size_t)(n0 + n) * K + k0 + kq * 16);
    d[0] = pk8(v); d[1] = pk8(v + 8);
  }
  __syncthreads();
}

DI void phase0(const Params& p, char* lds) {
  const int tid = otid();
  u16* win = (u16*)(p.ws + W_WIN); u16* wout = (u16*)(p.ws + W_WOUT); u16* wpg = (u16*)(p.ws + W_WPG); u16* wpe = (u16*)(p.ws + W_WPE);
  for (int it = vbid(); it < DEPTH * 1312; it += vgrid()) {
    const int l = it / 1312; int j = it % 1312;
    if (j < 736) { transpose_item(p.w_in + (size_t)l * DM * NIN, DM, NIN, p.norm_g + l * DM, win + (size_t)l * NINP * DM, (j / 46) * 64, (j % 46) * 64, (float*)lds); }
    else if (j < 992) { j -= 736; transpose_item(p.w_out + (size_t)l * DM * DM, DM, DM, nullptr, wout + (size_t)l * DM * DM, (j / 16) * 64, (j % 16) * 64, (float*)lds); }
    else if (j < 1248) { j -= 992; transpose_item(p.w_pg + (size_t)l * DM * DM, DM, DM, p.pe_norm_g + l * DM, wpg + (size_t)l * DM * DM, (j / 16) * 64, (j % 16) * 64, (float*)lds); }
    else { j -= 1248; transpose_item(p.w_pe + (size_t)l * DPLE * DM, DPLE, DM, nullptr, wpe + (size_t)l * DM * DPLE, (j / 16) * 64, (j % 16) * 64, (float*)lds); }
  }
  u16* hb = (u16*)(p.ws + W_MIX);
  float* ssA = (float*)(p.ws + W_SSA);
  const size_t gt = (size_t)vbid() * NTHR + tid, gs = (size_t)vgrid() * NTHR;
  for (int row = vbid() * 4 + (tid >> 6); row < TT; row += vgrid() * 4) {
    const int lane = tid & 63;
    const float* s = (row < TP ? p.x_prompt + (size_t)row * DM : p.x_sample + (size_t)(row - TP) * DM) + lane * 8;
    float sq = 0.f;
#pragma unroll
    for (int hf = 0; hf < 2; ++hf) {
      const float4 f0 = *(const float4*)(s + hf * 512), f1 = *(const float4*)(s + hf * 512 + 4);
      sq += f0.x * f0.x + f0.y * f0.y + f0.z * f0.z + f0.w * f0.w + f1.x * f1.x + f1.y * f1.y + f1.z * f1.z + f1.w * f1.w;
      *(uint4*)(hb + (size_t)row * DM + hf * 512 + lane * 8) = make_uint4(pk2(f0.x, f0.y), pk2(f0.z, f0.w), pk2(f1.x, f1.y), pk2(f1.z, f1.w));
    }
    sq += __shfl_xor(sq, 1); sq += __shfl_xor(sq, 2); sq += __shfl_xor(sq, 4); sq += __shfl_xor(sq, 8); sq += __shfl_xor(sq, 16); sq += __shfl_xor(sq, 32);
    if (lane == 0) ssA[row] = sq;
  }
  float* rope = (float*)(p.ws + W_ROPE);
  for (size_t i = gt; i < (size_t)TP * 8; i += gs) {
    const int pos = (int)(i >> 3), fi = (int)(i & 7);
    float inv = 1.0f;
    switch (fi) {
      case 1: inv = 0.1939227432012558f; break; case 2: inv = 0.03760603070259094f; break; case 3: inv = 0.007292664609849453f; break;
      case 4: inv = 0.0014142135623842478f; break; case 5: inv = 0.00027424818836152554f; break; case 6: inv = 5.3182957344688475e-05f; break;
      case 7: inv = 1.0313385246263351e-05f; break; default: break;
    }
    const float angf = (float)pos * inv;
    const double a = (double)angf;
    const double q = rint(a * 0.63661977236758134308);
    double rr = fma(-q, 1.57079632679489655800e+00, a);
    rr = fma(-q, 6.12323399573676603587e-17, rr);
    const double r2 = rr * rr;
    const double sn = rr * (1.0 + r2 * (-1.0 / 6 + r2 * (1.0 / 120 + r2 * (-1.0 / 5040 + r2 * (1.0 / 362880 + r2 * (-1.0 / 39916800))))));
    const double cs = 1.0 + r2 * (-0.5 + r2 * (1.0 / 24 + r2 * (-1.0 / 720 + r2 * (1.0 / 40320 + r2 * (-1.0 / 3628800 + r2 * (1.0 / 479001600))))));
    const int qi = ((int)q) & 3;
    double c, s;
    if (qi == 0) { c = cs; s = sn; } else if (qi == 1) { c = -sn; s = cs; } else if (qi == 2) { c = -cs; s = -sn; } else { c = sn; s = -cs; }
    rope[pos * 16 + fi] = (float)c;
    rope[pos * 16 + 8 + fi] = (float)s;
  }
}

DI void store_rows_bf16(const float* C, const float* rstd, u16* dst, int ld, int m0, int coloff, float scale, bool silu) {
  const int tid = otid();
#pragma unroll 1
  for (int it = 0; it < 8; ++it) {
    const int item = it * 256 + tid, row = item >> 4, cgp = item & 15;
    const float rs = rstd[row] * scale;
    float v[8];
    const float4 a = *(const float4*)(C + row * 132 + cgp * 8), b = *(const float4*)(C + row * 132 + cgp * 8 + 4);
    v[0] = a.x * rs; v[1] = a.y * rs; v[2] = a.z * rs; v[3] = a.w * rs; v[4] = b.x * rs; v[5] = b.y * rs; v[6] = b.z * rs; v[7] = b.w * rs;
    if (silu) {
#pragma unroll
      for (int j = 0; j < 8; ++j) v[j] = siluf_(v[j]);
    }
    *(uint4*)(dst + (size_t)(m0 + row) * ld + coloff + cgp * 8) = pk8(v);
  }
}
DI void store_cols_bf16T(const float* C, const float* rstd, u16* dstT, int m0, int colbase) {
  const int tid = otid();
#pragma unroll 1
  for (int it = 0; it < 8; ++it) {
    const int item = it * 256 + tid, col = item & 127, rg = item >> 7;
    float v[8];
#pragma unroll
    for (int j = 0; j < 8; ++j) v[j] = C[(rg * 8 + j) * 132 + col] * rstd[rg * 8 + j];
    *(uint4*)(dstT + (size_t)(colbase + col) * TPS + m0 + rg * 8) = pk8(v);
  }
}
DI void store_rows_f32_kv(const float* C, const float* rstd, float* out, size_t off_p, size_t off_s, int l, int m0) {
  const int tid = otid();
#pragma unroll 1
  for (int it = 0; it < 8; ++it) {
    const int item = it * 256 + tid, row = item >> 4, cgp = item & 15;
    const int grow = m0 + row;
    float* d;
    if (grow >= TP) d = out + off_s + ((size_t)l * TS + (grow - TP)) * 128;
    else if (grow >= TP - 128) d = out + off_p + ((size_t)l * 128 + (grow - (TP - 128))) * 128;
    else continue;
    const float rs = rstd[row];
    const float4 a = *(const float4*)(C + row * 132 + cgp * 8), b = *(const float4*)(C + row * 132 + cgp * 8 + 4);
    *(float4*)(d + cgp * 8) = make_float4(a.x * rs, a.y * rs, a.z * rs, a.w * rs);
    *(float4*)(d + cgp * 8 + 4) = make_float4(b.x * rs, b.y * rs, b.z * rs, b.w * rs);
  }
}

DI void phaseA(const Params& p, int l, char* lds, int vb) {
  const int tid = otid();
  float* C = (float*)lds;
  float* rstd = (float*)(lds + 128 * 132 * 4);
  const u16* hb = (const u16*)(p.ws + W_MIX);
  const u16* wt = (const u16*)(p.ws + W_WIN) + (size_t)l * NINP * DM;
  const float* rope = (const float*)(p.ws + W_ROPE);
  const float* ssA = (const float*)(p.ws + W_SSA);
  { float* ssD = (float*)(p.ws + W_SSD); for (int i = vbid() * NTHR + tid; i < TT; i += vgrid() * NTHR) ssD[i] = 0.f; }
  for (int rnd = 0;; ++rnd) {
    const int spos = seq_pos(rnd, vb);
    if (rnd * vgrid() >= MT * 23) break;
    if (spos >= MT * 23) continue;
    int mt, nt; pos_to_tile(spos, MT, 23, 8, mt, nt);
    const int m0 = mt * 128, n0 = nt * 128;
    f32x16 acc[2][2];
    for (int i = 0; i < 2; ++i) for (int j = 0; j < 2; ++j) acc[i][j] = zero16();
    float ss[4] = {0.f, 0.f, 0.f, 0.f};
    gemm_main<false, false>(hb + (size_t)m0 * DM, DM, wt + (size_t)n0 * DM, DM, DM, acc, lds, ss);
    acc_to_lds(acc, C);
    if (tid < 128) rstd[tid] = rsqrtf(ssA[m0 + tid] * (1.f / DM) + 1e-6f);
    __syncthreads();
    if (n0 < 640) {
      const bool isq = n0 < 512;
      const float* gn = (isq ? p.q_norm_g : p.k_norm_g) + l * 64;
#pragma unroll 1
      for (int it = 0; it < 8; ++it) {
        const int item = it * 256 + tid, row = item >> 4, cgp = item & 15;
        const int grow = m0 + row, d0 = (cgp & 7) * 8;
        const float rs = rstd[row];
        float v[8];
        const float4 a = *(const float4*)(C + row * 132 + cgp * 8), b = *(const float4*)(C + row * 132 + cgp * 8 + 4);
        v[0] = a.x * rs; v[1] = a.y * rs; v[2] = a.z * rs; v[3] = a.w * rs; v[4] = b.x * rs; v[5] = b.y * rs; v[6] = b.z * rs; v[7] = b.w * rs;
        float s = 0.f;
#pragma unroll
        for (int j = 0; j < 8; ++j) s += v[j] * v[j];
        s += __shfl_xor(s, 1); s += __shfl_xor(s, 2); s += __shfl_xor(s, 4);
        const float hr = rsqrtf(s * (1.f / 64) + 1e-6f);
#pragma unroll
        for (int j = 0; j < 8; ++j) v[j] = v[j] * hr * gn[d0 + j];
        const int pos = grow < TP ? grow : 1024 + ((grow - TP) & 15);
        float pr[8];
#pragma unroll
        for (int j = 0; j < 8; ++j) pr[j] = __shfl_xor(v[j], 1);
        if ((cgp & 7) < 2) {
          const float4 c0 = *(const float4*)(rope + pos * 16), c1 = *(const float4*)(rope + pos * 16 + 4);
          const float4 s0 = *(const float4*)(rope + pos * 16 + 8), s1 = *(const float4*)(rope + pos * 16 + 12);
          const float cs[8] = {c0.x, c0.y, c0.z, c0.w, c1.x, c1.y, c1.z, c1.w};
          const float sn[8] = {s0.x, s0.y, s0.z, s0.w, s1.x, s1.y, s1.z, s1.w};
          const float sg = ((cgp & 7) == 0) ? -1.f : 1.f;
#pragma unroll
          for (int j = 0; j < 8; ++j) v[j] = v[j] * cs[j] + sg * pr[j] * sn[j];
        }
        if (isq) {
#pragma unroll
          for (int j = 0; j < 8; ++j) v[j] *= 0.125f;
          *(uint4*)((u16*)(p.ws + W_Q) + (size_t)grow * 512 + n0 + cgp * 8) = pk8(v);
        } else {
          *(uint4*)((u16*)(p.ws + W_K) + (size_t)grow * 128 + cgp * 8) = pk8(v);
          float* d = nullptr;
          if (grow >= TP) d = p.out + O_KS + ((size_t)l * TS + (grow - TP)) * 128;
          else if (grow >= TP - 128) d = p.out + O_KP + ((size_t)l * 128 + (grow - (TP - 128))) * 128;
          if (d) {
            *(float4*)(d + cgp * 8) = make_float4(v[0], v[1], v[2], v[3]);
            *(float4*)(d + cgp * 8 + 4) = make_float4(v[4], v[5], v[6], v[7]);
          }
        }
      }
    } else if (n0 == 640) {
      if (m0 < TP) store_cols_bf16T(C, rstd, (u16*)(p.ws + W_VT), m0, 0);
      if (m0 >= TP - 128) store_rows_f32_kv(C, rstd, p.out, O_VP, O_VS, l, m0);
    } else if (n0 < 1280) {
      store_rows_bf16(C, rstd, (u16*)(p.ws + W_GATE), DM, m0, n0 - 768, 1.f, true);
    } else if (n0 < 1536) {
      store_rows_bf16(C, rstd, (u16*)(p.ws + W_QB), 256, m0, n0 - 1280, 0.125f, false);
    } else if (n0 < 1792) {
      store_rows_bf16(C, rstd, (u16*)(p.ws + W_KB), 256, m0, n0 - 1536, 1.f, false);
      if (m0 < TP) store_cols_bf16T(C, rstd, (u16*)(p.ws + W_KBT), m0, n0 - 1536);
    } else if (n0 < 2304) {
      if (m0 < TP) store_cols_bf16T(C, rstd, (u16*)(p.ws + W_VBT), m0, n0 - 1792);
      else store_rows_bf16(C, rstd, (u16*)(p.ws + W_VBS), 512, m0 - TP, n0 - 1792, 1.f, false);
    } else if (n0 < 2816) {
      store_rows_bf16(C, rstd, (u16*)(p.ws + W_GATE), DM, m0, 512 + n0 - 2304, 1.f, true);
    } else {
      float* ab = (float*)(p.ws + W_AB);
      for (int item = tid; item < 128 * 4; item += 256) {
        const int row = item >> 2, c4 = item & 3;
        const float rs = rstd[row];
        const float4 a = *(const float4*)(C + row * 132 + c4 * 4);
        *(float4*)(ab + (size_t)(m0 + row) * 16 + c4 * 4) = make_float4(a.x * rs, a.y * rs, a.z * rs, a.w * rs);
      }
    }
    __syncthreads();
  }
}

namespace pg8 {
typedef float f32x4 __attribute__((ext_vector_type(4)));
constexpr int BM = 256, BK = 64, HALF = 128, HTB = HALF * BK * 2  , STAGE_BYTES = 8 * HTB, NXCD = 8, WGM = 8;
DI int lds_byte(int r, int c) { const int st = (r >> 4) * 2 + (c >> 5), rr = r & 15, cc = c & 31, ob = rr * 64 + cc * 2; return st * 1024 + (ob ^ (((ob >> 9) & 1) << 5)); }
DI void stage_rc(int b, int& R, int& C) { const int st = b / 1024, sb = b % 1024, swz = sb ^ (((sb >> 9) & 1) << 5); R = (st >> 1) * 16 + swz / 64; C = (st & 1) * 32 + (swz % 64) / 2; }
DI int perm32(int rho) { const int n = rho >> 4, i = rho & 15; return 8 * (i >> 2) + 4 * n + (i & 3); }
struct Unit { int pm, pn; };
struct Gemm { const u16* A; const u16* Bt; int M, N, K; };
struct StaticOrder {
  int nM, nN, nwg, G, c;
  DI void init(int M, int N, int G_, int c_) { nM = M / BM; nN = N / BM; nwg = nM * nN; G = G_; c = c_; }
  DI bool next(int i, Unit& u) const {
    const long L = (long)i * G + c; if (L >= nwg) return false;
    int wgid = (int)L; { const int q = nwg / NXCD, r = nwg % NXCD, xcd = wgid % NXCD, off = wgid / NXCD; wgid = (xcd < r ? xcd * (q + 1) : r * (q + 1) + (xcd - r) * q) + off; }
    const int nig = WGM * nN, gid = wgid / nig, fm = gid * WGM, gsz = (nM - fm) < WGM ? (nM - fm) : WGM;
    u.pm = fm + ((wgid % nig) % gsz); u.pn = (wgid % nig) / gsz; return true;
  }
};
template <class Epi>
DI void gemm_phase(LAS unsigned char* lds, const Gemm g, const StaticOrder& S, const Epi& E) {
  int tid_ = threadIdx.x; asm volatile("" : "+v"(tid_));
  const int tid = tid_, wid = __builtin_amdgcn_readfirstlane(tid >> 6), lane = tid & 63, wr = wid >> 2, wc = wid & 3, fr = lane & 15, fq = lane >> 4;
  const int K = g.K, nt = K / BK;
  unsigned voffA[2], voffB0[2];
#pragma unroll
  for (int i = 0; i < 2; ++i) { int R, C; stage_rc(tid * 16 + i * 8192, R, C); const int Rb = 64 * (R >> 5) + perm32(R & 31);
    voffA[i] = (unsigned)(R * K + C) * 2u; voffB0[i] = (unsigned)(Rb * K + C) * 2u; }
  const size_t b1off = (size_t)32 * K * 2;
  const size_t kstep = (size_t)(BK * 2);
  const size_t hstep = (size_t)HALF * K * 2;
  const size_t tstep = 2 * hstep;
  const unsigned ldsw = (unsigned)wid * 1024u;
  const int aoff = lds_byte(wr * 64 + fr, fq * 8), boff = lds_byte(wc * 32 + fr, fq * 8);
#define PG8_SA(b, h) (((b) * 2 + (h)) * HTB)
#define PG8_SB(b, h) ((4 + (b) * 2 + (h)) * HTB)
#define PG8_STAGE(bufoff, gbase, voff) do { _Pragma("unroll") for (int _i = 0; _i < 2; ++_i) \
    __builtin_amdgcn_global_load_lds((const unsigned*)((const char*)(gbase) + (voff)[_i]), (LAS unsigned*)(lds + (bufoff) + ldsw + _i * 8192), 16, 0, 0); } while (0)
#define PG8_LDA(dst, b, h) do { _Pragma("unroll") for (int m = 0; m < 4; ++m) _Pragma("unroll") for (int k = 0; k < 2; ++k) dst[m][k] = *(const LAS bf16x8*)(lds + PG8_SA(b, h) + aoff + m * 2048 + k * 1024); } while (0)
#define PG8_LDB(dst, b, h) do { _Pragma("unroll") for (int n = 0; n < 2; ++n) _Pragma("unroll") for (int k = 0; k < 2; ++k) dst[n][k] = *(const LAS bf16x8*)(lds + PG8_SB(b, h) + boff + n * 2048 + k * 1024); } while (0)
#define PG8_MMA(ai, bj, At, Bt) do { __builtin_amdgcn_s_setprio(1); _Pragma("unroll") for (int m = 0; m < 4; ++m) _Pragma("unroll") for (int n = 0; n < 2; ++n) _Pragma("unroll") for (int k = 0; k < 2; ++k) \
    acc[ai][bj][m][n] = __builtin_amdgcn_mfma_f32_16x16x32_bf16(Bt[n][k], At[m][k], acc[ai][bj][m][n], 0, 0, 0); __builtin_amdgcn_s_setprio(0); } while (0)
#define PG8_WAIT_V(n) asm volatile("s_waitcnt vmcnt(" #n ")" ::: "memory")
#define PG8_WAIT_L(n) asm volatile("s_waitcnt lgkmcnt(" #n ")" ::: "memory")
#define PG8_BAR __builtin_amdgcn_s_barrier()
#define PG8_SCHED __builtin_amdgcn_sched_barrier(0)
  Unit cur, nxt; int ui = 0;
  if (!S.next(0, cur)) return;
  f32x4 acc[2][2][4][2];
#pragma unroll
  for (int a = 0; a < 2; ++a)
#pragma unroll
    for (int b = 0; b < 2; ++b)
#pragma unroll
      for (int m = 0; m < 4; ++m)
#pragma unroll
        for (int n = 0; n < 2; ++n) acc[a][b][m][n] = (f32x4){0.f, 0.f, 0.f, 0.f};
  bf16x8 At[4][2], B0[2][2], B1[2][2];
  const char* cA = (const char*)g.A + (size_t)cur.pm * tstep; const char* cB = (const char*)g.Bt + (size_t)cur.pn * tstep;
  PG8_STAGE(PG8_SB(0, 0), cB, voffB0); PG8_STAGE(PG8_SA(0, 0), cA, voffA); PG8_STAGE(PG8_SB(0, 1), cB + b1off, voffB0); PG8_STAGE(PG8_SA(0, 1), cA + hstep, voffA);
  if (wr == 1) PG8_BAR;
  PG8_WAIT_V(4); PG8_BAR;
  PG8_STAGE(PG8_SB(1, 0), cB + kstep, voffB0); PG8_STAGE(PG8_SA(1, 0), cA + kstep, voffA); PG8_STAGE(PG8_SB(1, 1), cB + kstep + b1off, voffB0);
  PG8_WAIT_V(6); PG8_BAR;
  for (;;) {
    const bool has_next = S.next(ui + 1, nxt);
    const char* nA = has_next ? (const char*)g.A + (size_t)nxt.pm * tstep : cA; const char* nB = has_next ? (const char*)g.Bt + (size_t)nxt.pn * tstep : cB;
    for (int t = 0; t < nt; t += 2) {
      const bool last = (t == nt - 2);
      const char* a1 = cA + (size_t)(t + 1) * kstep;
      const char* a2 = last ? nA : cA + (size_t)(t + 2) * kstep; const char* b2 = last ? nB : cB + (size_t)(t + 2) * kstep;
      const char* a3 = a2 + kstep; const char* b3 = b2 + kstep;
      PG8_LDB(B0, 0, 0); PG8_SCHED; PG8_LDA(At, 0, 0); PG8_STAGE(PG8_SA(1, 1), a1 + hstep, voffA);
      PG8_WAIT_L(8); PG8_BAR; PG8_WAIT_L(0); PG8_MMA(0, 0, At, B0); PG8_BAR; PG8_SCHED;
      PG8_LDB(B1, 0, 1); PG8_STAGE(PG8_SB(0, 0), b2, voffB0);
      PG8_BAR; PG8_WAIT_L(0); PG8_MMA(0, 1, At, B1); PG8_BAR;
      PG8_LDA(At, 0, 1); PG8_STAGE(PG8_SA(0, 0), a2, voffA);
      PG8_BAR; PG8_WAIT_L(0); PG8_MMA(1, 0, At, B0); PG8_BAR; PG8_SCHED;
      PG8_STAGE(PG8_SB(0, 1), b2 + b1off, voffB0);
      PG8_WAIT_V(6); PG8_BAR; PG8_MMA(1, 1, At, B1); PG8_BAR;
      PG8_LDB(B0, 1, 0); PG8_SCHED; PG8_LDA(At, 1, 0); PG8_STAGE(PG8_SA(0, 1), a2 + hstep, voffA);
      PG8_WAIT_L(8); PG8_BAR; PG8_WAIT_L(0); PG8_MMA(0, 0, At, B0); PG8_BAR; PG8_SCHED;
      PG8_LDB(B1, 1, 1); PG8_STAGE(PG8_SB(1, 0), b3, voffB0);
      PG8_BAR; PG8_WAIT_L(0); PG8_MMA(0, 1, At, B1); PG8_BAR;
      PG8_LDA(At, 1, 1); PG8_STAGE(PG8_SA(1, 0), a3, voffA);
      PG8_BAR; PG8_WAIT_L(0); PG8_MMA(1, 0, At, B0); PG8_BAR; PG8_SCHED;
      PG8_STAGE(PG8_SB(1, 1), b3 + b1off, voffB0);
      PG8_WAIT_V(6); PG8_BAR; PG8_MMA(1, 1, At, B1); PG8_BAR;
    }
    E(acc, cur, wr, wc, fr, fq);
    if (!has_next) break;
#pragma unroll
    for (int a = 0; a < 2; ++a)
#pragma unroll
      for (int b = 0; b < 2; ++b)
#pragma unroll
        for (int m = 0; m < 4; ++m)
#pragma unroll
          for (int n = 0; n < 2; ++n) acc[a][b][m][n] = (f32x4){0.f, 0.f, 0.f, 0.f};
    cur = nxt; cA = nA; cB = nB; ++ui;
  }
  PG8_WAIT_V(0);
  if (wr == 0) PG8_BAR;
  PG8_BAR;
#undef PG8_SA
#undef PG8_SB
#undef PG8_STAGE
#undef PG8_LDA
#undef PG8_LDB
#undef PG8_MMA
#undef PG8_WAIT_V
#undef PG8_WAIT_L
#undef PG8_BAR
#undef PG8_SCHED
}
}

DI u16 bf1(float x) { return (u16)(pk2(x, 0.f) & 0xffffu); }
struct EpiA {
  char* ws; float* out; const float* qng; const float* kng; int l;
  template <int SEG>
  DI void rows(const pg8::f32x4 (&acc)[2][2][4][2], const pg8::Unit& u, int cb, int wr, int fr, int fq) const {
    const float* ssA = (const float*)(ws + W_SSA);
    const bool sample = u.pm >= TP / 256;
    const int c0 = 8 * fq;
    float rsv[8];
#pragma unroll
    for (int i = 0; i < 8; ++i) rsv[i] = ssA[u.pm * 256 + (i >> 2) * 128 + wr * 64 + (i & 3) * 16 + fr];
#pragma unroll
    for (int i = 0; i < 8; ++i) rsv[i] = rsqrtf(rsv[i] * (1.f / DM) + 1e-6f);
#pragma unroll
    for (int ai = 0; ai < 2; ++ai)
#pragma unroll
      for (int m = 0; m < 4; ++m) {
        const int row = u.pm * 256 + ai * 128 + wr * 64 + m * 16 + fr;
        const float rs = rsv[ai * 4 + m];
        float x[2][8];
#pragma unroll
        for (int bj = 0; bj < 2; ++bj)
#pragma unroll
          for (int n = 0; n < 2; ++n)
#pragma unroll
            for (int j = 0; j < 4; ++j) x[bj][4 * n + j] = acc[ai][bj][m][n][j] * rs;
        if (SEG < 2) {
          float sq = 0.f;
#pragma unroll
          for (int bj = 0; bj < 2; ++bj)
#pragma unroll
            for (int e = 0; e < 8; ++e) sq += x[bj][e] * x[bj][e];
          sq += __shfl_xor(sq, 16); sq += __shfl_xor(sq, 32);
          const float hr = rsqrtf(sq * (1.f / 64) + 1e-6f);
          const float* gp = (SEG == 0 ? qng : kng) + c0;
#pragma unroll
          for (int bj = 0; bj < 2; ++bj) {
            const float4 a = *(const float4*)(gp + 32 * bj), b = *(const float4*)(gp + 32 * bj + 4);
            x[bj][0] *= hr * a.x; x[bj][1] *= hr * a.y; x[bj][2] *= hr * a.z; x[bj][3] *= hr * a.w;
            x[bj][4] *= hr * b.x; x[bj][5] *= hr * b.y; x[bj][6] *= hr * b.z; x[bj][7] *= hr * b.w;
          }
          const int pos = row < TP ? row : 1024 + ((row - TP) & 15);
          const float* rp = (const float*)(ws + W_ROPE) + pos * 16;
          float rpc[16];
#pragma unroll
          for (int e = 0; e < 16; e += 4) { const float4 t = *(const float4*)(rp + e); rpc[e] = t.x; rpc[e + 1] = t.y; rpc[e + 2] = t.z; rpc[e + 3] = t.w; }
          const float sg = fq == 0 ? -1.f : 1.f;
#pragma unroll
          for (int e = 0; e < 8; ++e) {
            const float pr = __shfl_xor(x[0][e], 16);
            if (fq < 2) x[0][e] = x[0][e] * rpc[e] + sg * pr * rpc[8 + e];
          }
          if (SEG == 0) {
#pragma unroll
            for (int bj = 0; bj < 2; ++bj) {
#pragma unroll
              for (int e = 0; e < 8; ++e) x[bj][e] *= 0.125f;
              *(uint4*)((u16*)(ws + W_Q) + (size_t)row * 512 + cb + 32 * bj + c0) = pk8(x[bj]);
            }
          } else {
            const int kc = cb - 512;
            float* d = nullptr;
            if (row >= TP) d = out + O_KS + ((size_t)l * TS + (row - TP)) * 128;
            else if (row >= TP - 128) d = out + O_KP + ((size_t)l * 128 + (row - (TP - 128))) * 128;
#pragma unroll
            for (int bj = 0; bj < 2; ++bj) {
              *(uint4*)((u16*)(ws + W_K) + (size_t)row * 128 + kc + 32 * bj + c0) = pk8(x[bj]);
              if (d) { *(float4*)(d + kc + 32 * bj + c0) = make_float4(x[bj][0], x[bj][1], x[bj][2], x[bj][3]); *(float4*)(d + kc + 32 * bj + c0 + 4) = make_float4(x[bj][4], x[bj][5], x[bj][6], x[bj][7]); }
            }
          }
        } else if (SEG == 2) {
          const int vc = cb - 640;
          float* d = nullptr;
          if (row >= TP) d = out + O_VS + ((size_t)l * TS + (row - TP)) * 128;
          else if (row >= TP - 128) d = out + O_VP + ((size_t)l * 128 + (row - (TP - 128))) * 128;
#pragma unroll
          for (int bj = 0; bj < 2; ++bj) {
            if (!sample) {
              u16* vT = (u16*)(ws + W_VT) + tidx(128, vc + 32 * bj + c0, row);
#pragma unroll
              for (int e = 0; e < 8; ++e) vT[e * 64] = bf1(x[bj][e]);
            }
            if (d) { *(float4*)(d + vc + 32 * bj + c0) = make_float4(x[bj][0], x[bj][1], x[bj][2], x[bj][3]); *(float4*)(d + vc + 32 * bj + c0 + 4) = make_float4(x[bj][4], x[bj][5], x[bj][6], x[bj][7]); }
          }
        } else if (SEG == 3 || SEG == 7) {
          const int gc = SEG == 3 ? cb - 768 : 512 + cb - 2304;
#pragma unroll
          for (int bj = 0; bj < 2; ++bj) {
#pragma unroll
            for (int e = 0; e < 8; ++e) x[bj][e] = siluf_(x[bj][e]);
            *(uint4*)((u16*)(ws + W_GATE) + (size_t)row * DM + gc + 32 * bj + c0) = pk8(x[bj]);
          }
        } else if (SEG == 4) {
#pragma unroll
          for (int bj = 0; bj < 2; ++bj) {
#pragma unroll
            for (int e = 0; e < 8; ++e) x[bj][e] *= 0.125f;
            *(uint4*)((u16*)(ws + W_QB) + (size_t)row * 256 + (cb - 1280) + 32 * bj + c0) = pk8(x[bj]);
          }
        } else if (SEG == 5) {
#pragma unroll
          for (int bj = 0; bj < 2; ++bj) {
            *(uint4*)((u16*)(ws + W_KB) + (size_t)row * 256 + (cb - 1536) + 32 * bj + c0) = pk8(x[bj]);
            if (!sample) {
              u16* kT = (u16*)(ws + W_KBT) + tidx(256, cb - 1536 + 32 * bj + c0, row);
#pragma unroll
              for (int e = 0; e < 8; ++e) kT[e * 64] = bf1(x[bj][e]);
            }
          }
        } else {
#pragma unroll
          for (int bj = 0; bj < 2; ++bj) {
            if (!sample) {
              u16* vT = (u16*)(ws + W_VBT) + tidx(512, cb - 1792 + 32 * bj + c0, row);
#pragma unroll
              for (int e = 0; e < 8; ++e) vT[e * 64] = bf1(x[bj][e]);
            } else {
              *(uint4*)((u16*)(ws + W_VBS) + (size_t)(row - TP) * 512 + (cb - 1792) + 32 * bj + c0) = pk8(x[bj]);
            }
          }
        }
        if (m & 1) asm volatile("" ::: "memory");
      }
  }
  DI void operator()(const pg8::f32x4 (&acc)[2][2][4][2], const pg8::Unit& u, int wr, int wc, int fr, int fq) const {
    const int cb = u.pn * 256 + wc * 64;
    if (cb < 512) rows<0>(acc, u, cb, wr, fr, fq);
    else if (cb < 640) rows<1>(acc, u, cb, wr, fr, fq);
    else if (cb < 768) rows<2>(acc, u, cb, wr, fr, fq);
    else if (cb < 1280) rows<3>(acc, u, cb, wr, fr, fq);
    else if (cb < 1536) rows<4>(acc, u, cb, wr, fr, fq);
    else if (cb < 1792) rows<5>(acc, u, cb, wr, fr, fq);
    else if (cb < 2304) rows<6>(acc, u, cb, wr, fr, fq);
    else rows<7>(acc, u, cb, wr, fr, fq);
  }
};

DI void phaseA8(const Params& p, int l, char* lds_all) {
  { int t0 = threadIdx.x; asm volatile("" : "+v"(t0));
    float* ssD = (float*)(p.ws + W_SSD);
    const int per = (TT + (int)gridDim.x - 1) / (int)gridDim.x, i = (int)blockIdx.x * per + t0;
    if (t0 < per && i < TT) ssD[i] = 0.f; }
  const u16* hb = (const u16*)(p.ws + W_MIX);
  const u16* wt = (const u16*)(p.ws + W_WIN) + (size_t)l * NINP * DM;
  pg8::Gemm g{hb, wt, TT, 2816, DM};
  pg8::StaticOrder S; S.init(TT, 2816, (int)gridDim.x, obid());
  EpiA E{p.ws, p.out, p.q_norm_g + l * 64, p.k_norm_g + l * 64, l};
  pg8::gemm_phase<EpiA>((LAS unsigned char*)lds_all, g, S, E);
  {
    int t2 = threadIdx.x; asm volatile("" : "+v"(t2));
    const int wid = t2 >> 6, lane = t2 & 63, r = lane & 31, hh = lane >> 5;
    const int gw = ((int)gridDim.x - 1 - (int)blockIdx.x) * 8 + wid;
    if (gw < TT / 32) {
      const int row0 = gw * 32;
      const u16* ap = hb + (size_t)(row0 + r) * DM + 8 * hh;
      const u16* bp = wt + (size_t)(2816 + r) * DM + 8 * hh;
      f32x16 acc = zero16();
#pragma unroll 16
      for (int ks = 0; ks < 64; ++ks) acc = MFMA(*(const bf16x8*)(ap + ks * 16), *(const bf16x8*)(bp + ks * 16), acc);
      const float* ssA = (const float*)(p.ws + W_SSA);
      float* ab = (float*)(p.ws + W_AB);
      if (r < 16) {
#pragma unroll
        for (int gi = 0; gi < 16; ++gi) { const int row = row0 + crow(gi, hh); ab[(size_t)row * 16 + r] = acc[gi] * rsqrtf(ssA[row] * (1.f / DM) + 1e-6f); }
      }
    }
  }
}

DI void phaseB(const Params& p, int l, char* lds) {
  const int tid = otid(), lane = tid & 63, w = tid >> 6, r = lane & 31, hh = lane >> 5;
  float* bN = (float*)lds;
  float* bT = bN + 64 * 65;
  float* tot = bT + 64 * 68;
  float* blast = tot + 256;
  const float* ab = (const float*)(p.ws + W_AB);
  u16* qb = (u16*)(p.ws + W_QB); u16* kb = (u16*)(p.ws + W_KB);
  const u16* kbT = (const u16*)(p.ws + W_KBT); const u16* vbT = (const u16*)(p.ws + W_VBT);
  float* Sb = (float*)(p.ws + W_S); float* dec = (float*)(p.ws + W_DEC);
  { float* ssA = (float*)(p.ws + W_SSA);
    const int per = (TT + vgrid() - 1) / vgrid(), i = vbid() * per + tid;
    if (tid < per && i < TT) ssA[i] = 0.f; }
  for (int item = vbid(); item < NCH * 4; item += vgrid()) {
    const int c = item >> 2, h = item & 3;
    {
      const int k = tid & 63, g = tid >> 6;
      float wg[16];
#pragma unroll
      for (int j = 0; j < 16; ++j) wg[j] = p.w_gate_up[((size_t)l * 16 + j) * 256 + h * 64 + k];
      const float bias = p.b_gate[l * 256 + h * 64 + k];
      float loc[16]; float cum = 0.f;
#pragma unroll
      for (int i = 0; i < 16; ++i) {
        const float* a = ab + (size_t)(c * 64 + g * 16 + i) * 16;
        const float4 a0 = *(const float4*)a, a1 = *(const float4*)(a + 4), a2 = *(const float4*)(a + 8), a3 = *(const float4*)(a + 12);
        float z = bias + a0.x * wg[0] + a0.y * wg[1] + a0.z * wg[2] + a0.w * wg[3] + a1.x * wg[4] + a1.y * wg[5] + a1.z * wg[6] + a1.w * wg[7]
                  + a2.x * wg[8] + a2.y * wg[9] + a2.z * wg[10] + a2.w * wg[11] + a3.x * wg[12] + a3.y * wg[13] + a3.z * wg[14] + a3.w * wg[15];
        cum += logsigmoidf_(z) * (1.f / 16);
        loc[i] = cum;
      }
      tot[g * 64 + k] = cum;
      __syncthreads();
      float off = 0.f;
      for (int g2 = 0; g2 < g; ++g2) off += tot[g2 * 64 + k];
#pragma unroll
      for (int i = 0; i < 16; ++i) {
        const int t = g * 16 + i; const float bv = loc[i] + off;
        bN[t * 65 + k] = bv; bT[k * 68 + t] = bv;
      }
      if (g == 3) { const float bl = loc[15] + off; blast[k] = bl; dec[(size_t)item * 64 + k] = __expf(bl); }
      __syncthreads();
    }
#pragma unroll
    for (int i = 0; i < 2; ++i) {
      const int grp = tid + 256 * i, t = grp >> 3, kc = grp & 7;
      const size_t off = (size_t)(c * 64 + t) * 256 + h * 64 + kc * 8;
      float qv[8], kv[8];
      unpk8(*(const uint4*)(qb + off), qv); unpk8(*(const uint4*)(kb + off), kv);
#pragma unroll
      for (int j = 0; j < 8; ++j) { const float bb = bN[t * 65 + kc * 8 + j]; qv[j] *= __expf(bb); kv[j] *= __expf(-bb); }
      *(uint4*)(qb + off) = pk8(qv); *(uint4*)(kb + off) = pk8(kv);
    }
    {
      f32x16 acc[2] = {zero16(), zero16()};
#pragma unroll
      for (int s = 0; s < 4; ++s) {
        const int t0 = 16 * s + 8 * hh;
        const bf16x8 vf = *(const bf16x8*)(vbT + tidx(512, h * 128 + w * 32 + r, c * 64 + t0));
#pragma unroll
        for (int kt = 0; kt < 2; ++kt) {
          const int k = kt * 32 + r;
          float kv[8];
          unpk8(*(const uint4*)(kbT + tidx(256, h * 64 + k, c * 64 + t0)), kv);
          const float bl = blast[k];
          const float4 b0 = *(const float4*)(bT + k * 68 + t0), b1 = *(const float4*)(bT + k * 68 + t0 + 4);
          kv[0] *= __expf(bl - b0.x); kv[1] *= __expf(bl - b0.y); kv[2] *= __expf(bl - b0.z); kv[3] *= __expf(bl - b0.w);
          kv[4] *= __expf(bl - b1.x); kv[5] *= __expf(bl - b1.y); kv[6] *= __expf(bl - b1.z); kv[7] *= __expf(bl - b1.w);
          acc[kt] = MFMA(vf, as_frag(pk8(kv)), acc[kt]);
        }
      }
#pragma unroll
      for (int kt = 0; kt < 2; ++kt)
#pragma unroll
        for (int g = 0; g < 16; ++g) Sb[(size_t)item * 8192 + (size_t)(w * 32 + crow(g, hh)) * 64 + kt * 32 + r] = acc[kt][g];
    }
    __syncthreads();
  }
}

DI void scan_item(const Params& p, int l, int it) {
  const int e = it * 256 + otid();
  const int h = e >> 13, v = (e >> 6) & 127, k = e & 63;
  float* Sb = (float*)(p.ws + W_S) + e;
  const float* dec = (const float*)(p.ws + W_DEC) + h * 64 + k;
  float S = 0.f;
  for (int c0 = 0; c0 < NCH; c0 += 16) {
    float d[16], g[16];
#pragma unroll
    for (int j = 0; j < 16; ++j) { d[j] = Sb[(size_t)(c0 + j) * 32768]; g[j] = dec[(size_t)(c0 + j) * 256]; }
#pragma unroll
    for (int j = 0; j < 16; ++j) { Sb[(size_t)(c0 + j) * 32768] = S; S = g[j] * S + d[j]; }
  }
  p.out[O_SP + (size_t)l * 32768 + h * 8192 + k * 128 + v] = S;
}

DI void attn_prompt_item(const Params& p, int l, int item, char* lds) {
  const int tid = otid(), lane = tid & 63, w = tid >> 6, r = lane & 31, hh = lane >> 5;
  const int c = item >> 2, kvh = (item >> 1) & 1, hp = item & 1;
  const int hq = kvh * 4 + hp * 2 + (w >> 1), qt = w & 1;
  const u16* q = (const u16*)(p.ws + W_Q); const u16* kbuf = (const u16*)(p.ws + W_K); const u16* vT = (const u16*)(p.ws + W_VT);
  const u16* gate = (const u16*)(p.ws + W_GATE); u16* mix = (u16*)(p.ws + W_MIX);
  const int qtok = c * 64 + qt * 32 + r;
  const int kt0 = c >= 2 ? 0 : (2 - c) * 2;
  const int kbase = (c - 2) * 64;
  char* Ks = lds;
  char* Vs = lds + 24576;
  char* Qs = lds + 49152 + w * 4096;
  {
    uint4 kr[6], vr[6], qr[4];
#pragma unroll
    for (int i = 0; i < 6; ++i) {
      const int idx = i * 256 + tid, row = idx >> 3, c16 = idx & 7;
      kr[i] = *(const uint4*)(kbuf + (size_t)max(kbase + row, 0) * 128 + kvh * 64 + c16 * 8);
      const int jc = max(c - 2 + (row >> 6), 0);
      vr[i] = *(const uint4*)(vT + ((size_t)jc * 128 + kvh * 64 + (row & 63)) * 64 + c16 * 8);
    }
#pragma unroll
    for (int i = 0; i < 4; ++i) {
      const int idx = i * 64 + lane, row = idx >> 3, c16 = idx & 7;
      qr[i] = *(const uint4*)(q + (size_t)(c * 64 + qt * 32 + row) * 512 + hq * 64 + c16 * 8);
    }
#pragma unroll
    for (int i = 0; i < 6; ++i) {
      const int idx = i * 256 + tid, row = idx >> 3, c16 = idx & 7;
      *(uint4*)(Ks + row * 128 + ((c16 ^ ((row >> 1) & 7)) << 4)) = kr[i];
      *(uint4*)(Vs + row * 128 + ((c16 ^ (row & 7)) << 4)) = vr[i];
    }
#pragma unroll
    for (int i = 0; i < 4; ++i) {
      const int idx = i * 64 + lane, row = idx >> 3, c16 = idx & 7;
      *(uint4*)(Qs + row * 128 + ((c16 ^ ((row >> 1) & 7)) << 4)) = qr[i];
    }
  }
  __syncthreads();
  bf16x8 qf[4];
#pragma unroll
  for (int ks = 0; ks < 4; ++ks) qf[ks] = *(const bf16x8*)(Qs + r * 128 + (((2 * ks + hh) ^ ((r >> 1) & 7)) << 4));
  f32x16 s[6];
#pragma unroll
  for (int kt = 0; kt < 6; ++kt) {
    s[kt] = zero16();
    const int krow = kt * 32 + r;
#pragma unroll
    for (int ks = 0; ks < 4; ++ks) s[kt] = MFMA(*(const bf16x8*)(Ks + krow * 128 + (((2 * ks + hh) ^ ((krow >> 1) & 7)) << 4)), qf[ks], s[kt]);
  }
  uint2 gpre[8];
#pragma unroll
  for (int i = 0; i < 8; ++i) gpre[i] = *(const uint2*)(gate + (size_t)qtok * DM + hq * 64 + (i >> 2) * 32 + 8 * (i & 3) + 4 * hh);
  const float sink = p.sinks[l * 8 + hq];
  float m = sink;
#pragma unroll
  for (int kt = 0; kt < 6; ++kt) {
    const float msk = kt >= kt0 ? 0.f : -1e30f;
#pragma unroll
    for (int g = 0; g < 16; ++g) { s[kt][g] += msk; m = fmaxf(m, s[kt][g]); }
  }
  m = fmaxf(m, __shfl_xor(m, 32));
  float den = 0.f;
#pragma unroll
  for (int kt = 0; kt < 6; ++kt) {
#pragma unroll
    for (int g = 0; g < 16; ++g) { const float e = __expf(s[kt][g] - m); s[kt][g] = e; den += e; }
  }
  den += __shfl_xor(den, 32);
  den += __expf(sink - m);
  f32x16 o[2] = {zero16(), zero16()};
#pragma unroll
  for (int kt = 0; kt < 6; ++kt) {
#pragma unroll
    for (int s2 = 0; s2 < 2; ++s2) {
      const uint4 pf = make_uint4(pk2(s[kt][8 * s2], s[kt][8 * s2 + 1]), pk2(s[kt][8 * s2 + 2], s[kt][8 * s2 + 3]),
                                  pk2(s[kt][8 * s2 + 4], s[kt][8 * s2 + 5]), pk2(s[kt][8 * s2 + 6], s[kt][8 * s2 + 7]));
      const int slot = 8 * (kt & 1) + 4 * s2 + hh;
#pragma unroll
      for (int dt = 0; dt < 2; ++dt) {
        const int vrow = (kt >> 1) * 64 + dt * 32 + r;
        const char* vp = Vs + vrow * 128 + (slot & 1) * 8;
        const uint2 lo = *(const uint2*)(vp + ((((slot >> 1)) ^ (vrow & 7)) << 4)), hi = *(const uint2*)(vp + ((((slot >> 1) + 1) ^ (vrow & 7)) << 4));
        o[dt] = MFMA(as_frag(make_uint4(lo.x, lo.y, hi.x, hi.y)), as_frag(pf), o[dt]);
      }
    }
  }
  const float inv = 1.f / den;
#pragma unroll
  for (int dt = 0; dt < 2; ++dt)
#pragma unroll
    for (int g4 = 0; g4 < 4; ++g4) {
      const size_t off = (size_t)qtok * DM + hq * 64 + dt * 32 + 8 * g4 + 4 * hh;
      const uint2 gv = gpre[dt * 4 + g4];
      const float o0 = o[dt][4 * g4] * inv * bflo(gv.x), o1 = o[dt][4 * g4 + 1] * inv * bfhi(gv.x);
      const float o2 = o[dt][4 * g4 + 2] * inv * bflo(gv.y), o3 = o[dt][4 * g4 + 3] * inv * bfhi(gv.y);
      *(uint2*)(mix + off) = make_uint2(pk2(o0, o1), pk2(o2, o3));
    }
  __syncthreads();
}

DI void attn_sample_item(const Params& p, int l, int item, char* lds) {
  const int tid = otid();
  const int b = item >> 3, hq = item & 7, kvh = hq >> 2;
  float* sc = (float*)lds;
  float* qs = sc + 16 * 148;
  char* Ksm = lds + 13824;
  char* Vsm = Ksm + 144 * 144;
  const int t = tid >> 4, part = tid & 15;
  const int row = TP + b * 16 + t;
  const float* ck = p.cache_k + ((size_t)(l * 32 + b) * 128) * 128 + kvh * 64;
  const float* cv = p.cache_v + ((size_t)(l * 32 + b) * 128) * 128 + kvh * 64;
  const float* nk = p.out + O_KS + ((size_t)l * TS + b * 16) * 128 + kvh * 64;
  const float* nv = p.out + O_VS + ((size_t)l * TS + b * 16) * 128 + kvh * 64;
  {
    const u16* q = (const u16*)(p.ws + W_Q) + (size_t)row * 512 + hq * 64 + part * 4;
    const uint2 u = *(const uint2*)q;
    *(float4*)(qs + t * 68 + part * 4) = make_float4(bflo(u.x), bfhi(u.x), bflo(u.y), bfhi(u.y));
    float4 kr[9], vr[9];
#pragma unroll
    for (int i = 0; i < 9; ++i) {
      const int idx = i * 256 + tid, key = idx >> 4, c4 = idx & 15;
      kr[i] = *(const float4*)((key < 128 ? ck + (size_t)key * 128 : nk + (size_t)(key - 128) * 128) + c4 * 4);
      vr[i] = *(const float4*)((key < 128 ? cv + (size_t)key * 128 : nv + (size_t)(key - 128) * 128) + c4 * 4);
    }
#pragma unroll
    for (int i = 0; i < 9; ++i) {
      const int idx = i * 256 + tid, key = idx >> 4, c4 = idx & 15;
      *(uint2*)(Ksm + key * 144 + c4 * 8) = make_uint2(pk2(kr[i].x, kr[i].y), pk2(kr[i].z, kr[i].w));
      *(uint2*)(Vsm + key * 128 + c4 * 8) = make_uint2(pk2(vr[i].x, vr[i].y), pk2(vr[i].z, vr[i].w));
    }
  }
  __syncthreads();
  {
    float a[9];
#pragma unroll
    for (int i = 0; i < 9; ++i) a[i] = 0.f;
#pragma unroll 2
    for (int d = 0; d < 64; d += 8) {
      const float4 q0 = *(const float4*)(qs + t * 68 + d), q1 = *(const float4*)(qs + t * 68 + d + 4);
#pragma unroll
      for (int i = 0; i < 9; ++i) {
        float kv[8]; unpk8(*(const uint4*)(Ksm + (part * 9 + i) * 144 + d * 2), kv);
        a[i] += q0.x * kv[0] + q0.y * kv[1] + q0.z * kv[2] + q0.w * kv[3] + q1.x * kv[4] + q1.y * kv[5] + q1.z * kv[6] + q1.w * kv[7];
      }
    }
#pragma unroll
    for (int i = 0; i < 9; ++i) sc[t * 148 + part * 9 + i] = a[i];
  }
  const float sink = p.sinks[l * 8 + hq];
  float m = sink;
#pragma unroll
  for (int i = 0; i < 9; ++i) m = fmaxf(m, sc[t * 148 + part * 9 + i]);
  m = fmaxf(m, __shfl_xor(m, 1)); m = fmaxf(m, __shfl_xor(m, 2)); m = fmaxf(m, __shfl_xor(m, 4)); m = fmaxf(m, __shfl_xor(m, 8));
  float den = 0.f;
#pragma unroll
  for (int i = 0; i < 9; ++i) { const float e = __expf(sc[t * 148 + part * 9 + i] - m); den += e; sc[t * 148 + part * 9 + i] = e; }
  den += __shfl_xor(den, 1); den += __shfl_xor(den, 2); den += __shfl_xor(den, 4); den += __shfl_xor(den, 8);
  den += __expf(sink - m);
  __syncthreads();
  float o0 = 0.f, o1 = 0.f, o2 = 0.f, o3 = 0.f;
#pragma unroll 16
  for (int key = 0; key < 144; ++key) {
    const float pw = sc[t * 148 + key];
    const uint2 vv = *(const uint2*)(Vsm + key * 128 + part * 8);
    o0 += pw * bflo(vv.x); o1 += pw * bfhi(vv.x); o2 += pw * bflo(vv.y); o3 += pw * bfhi(vv.y);
  }
  const float inv = 1.f / den;
  const size_t off = (size_t)row * DM + hq * 64 + part * 4;
  const uint2 gv = *(const uint2*)((const u16*)(p.ws + W_GATE) + off);
  o0 *= inv * bflo(gv.x); o1 *= inv * bfhi(gv.x); o2 *= inv * bflo(gv.y); o3 *= inv * bfhi(gv.y);
  *(uint2*)((u16*)(p.ws + W_MIX) + off) = make_uint2(pk2(o0, o1), pk2(o2, o3));
  __syncthreads();
}

DI void gla_out_prompt(const Params& p, int l, int item, char* lds) {
  const int tid = otid(), lane = tid & 63, w = tid >> 6, r = lane & 31, hh = lane >> 5;
  const int c = item >> 2, h = item & 3;
  const int tt = w & 1, vh = w >> 1;
  char* Qs = lds;
  char* Ks = lds + 8192;
  char* Vs = lds + 16384;
  char* Ss = lds + 32768;
  char* Gs = lds + 49152;
  float* part = (float*)(lds + 65536);
  char* Os = lds;
  const u16* qtb = (const u16*)(p.ws + W_QB); const u16* ktb = (const u16*)(p.ws + W_KB); const u16* vbT = (const u16*)(p.ws + W_VBT);
  const float* Sb = (const float*)(p.ws + W_S) + (size_t)item * 8192;
  const u16* gate = (const u16*)(p.ws + W_GATE); u16* mix = (u16*)(p.ws + W_MIX);
  {
    uint4 qr[2], kr[2], vr[4], gr[4]; float4 sr[8];
#pragma unroll
    for (int i = 0; i < 2; ++i) {
      const int idx = i * 256 + tid, row = idx >> 3, c16 = idx & 7;
      qr[i] = *(const uint4*)(qtb + (size_t)(c * 64 + row) * 256 + h * 64 + c16 * 8);
      kr[i] = *(const uint4*)(ktb + (size_t)(c * 64 + row) * 256 + h * 64 + c16 * 8);
    }
#pragma unroll
    for (int i = 0; i < 4; ++i) {
      const int idx = i * 256 + tid, row = idx >> 3, c16 = idx & 7;
      vr[i] = *(const uint4*)(vbT + ((size_t)c * 512 + h * 128 + row) * 64 + c16 * 8);
      sr[2 * i] = *(const float4*)(Sb + (size_t)row * 64 + c16 * 8); sr[2 * i + 1] = *(const float4*)(Sb + (size_t)row * 64 + c16 * 8 + 4);
      const int grow = idx >> 4, g16 = idx & 15;
      gr[i] = *(const uint4*)(gate + (size_t)(c * 64 + grow) * DM + 512 + h * 128 + g16 * 8);
    }
#pragma unroll
    for (int i = 0; i < 2; ++i) {
      const int idx = i * 256 + tid, row = idx >> 3, c16 = idx & 7;
      *(uint4*)(Qs + row * 128 + ((c16 ^ ((row >> 1) & 7)) << 4)) = qr[i];
      *(uint4*)(Ks + row * 128 + ((c16 ^ ((row >> 1) & 7)) << 4)) = kr[i];
    }
#pragma unroll
    for (int i = 0; i < 4; ++i) {
      const int idx = i * 256 + tid, row = idx >> 3, c16 = idx & 7;
      *(uint4*)(Vs + row * 128 + ((c16 ^ (row & 7)) << 4)) = vr[i];
      *(uint4*)(Ss + row * 128 + ((c16 ^ ((row >> 1) & 7)) << 4)) = make_uint4(pk2(sr[2 * i].x, sr[2 * i].y), pk2(sr[2 * i].z, sr[2 * i].w), pk2(sr[2 * i + 1].x, sr[2 * i + 1].y), pk2(sr[2 * i + 1].z, sr[2 * i + 1].w));
      *(uint4*)(Gs + idx * 16) = gr[i];
    }
  }
  __syncthreads();
  const int t = tt * 32 + r, tok = c * 64 + t;
  bf16x8 qf[4];
#pragma unroll
  for (int ks = 0; ks < 4; ++ks) qf[ks] = *(const bf16x8*)(Qs + t * 128 + (((2 * ks + hh) ^ ((t >> 1) & 7)) << 4));
  f32x16 x0 = zero16(), x1 = zero16();
#pragma unroll
  for (int ks = 0; ks < 4; ++ks) {
    x0 = MFMA(*(const bf16x8*)(Ks + r * 128 + (((2 * ks + hh) ^ ((r >> 1) & 7)) << 4)), qf[ks], x0);
    x1 = MFMA(*(const bf16x8*)(Ks + (32 + r) * 128 + (((2 * ks + hh) ^ (((32 + r) >> 1) & 7)) << 4)), qf[ks], x1);
  }
#pragma unroll
  for (int g = 0; g < 16; ++g) {
    const bool keep = crow(g, hh) <= r;
    if (tt == 0) { if (!keep) x0[g] = 0.f; x1[g] = 0.f; } else { if (!keep) x1[g] = 0.f; }
  }
  f32x16 o[2] = {zero16(), zero16()};
#pragma unroll
  for (int vt = 0; vt < 2; ++vt) {
    const int v = (2 * vh + vt) * 32 + r;
#pragma unroll
    for (int st = 0; st < 2; ++st)
#pragma unroll
      for (int s2 = 0; s2 < 2; ++s2) {
        const f32x16& xx = st == 0 ? x0 : x1;
        const uint4 pf = make_uint4(pk2(xx[8 * s2], xx[8 * s2 + 1]), pk2(xx[8 * s2 + 2], xx[8 * s2 + 3]), pk2(xx[8 * s2 + 4], xx[8 * s2 + 5]), pk2(xx[8 * s2 + 6], xx[8 * s2 + 7]));
        const int slot = 8 * st + 4 * s2 + hh;
        const char* vp = Vs + v * 128 + (slot & 1) * 8;
        const uint2 lo = *(const uint2*)(vp + (((slot >> 1) ^ (v & 7)) << 4)), hi = *(const uint2*)(vp + ((((slot >> 1) + 1) ^ (v & 7)) << 4));
        o[vt] = MFMA(as_frag(make_uint4(lo.x, lo.y, hi.x, hi.y)), as_frag(pf), o[vt]);
      }
#pragma unroll
    for (int ks = 0; ks < 4; ++ks) o[vt] = MFMA(*(const bf16x8*)(Ss + v * 128 + (((2 * ks + hh) ^ ((v >> 1) & 7)) << 4)), qf[ks], o[vt]);
  }
  float sq = 0.f;
#pragma unroll
  for (int vt = 0; vt < 2; ++vt)
#pragma unroll
    for (int g = 0; g < 16; ++g) sq += o[vt][g] * o[vt][g];
  sq += __shfl_xor(sq, 32);
  if (hh == 0) part[vh * 64 + t] = sq;
  __syncthreads();
  const float rs = rsqrtf((part[t] + part[64 + t]) * (1.f / 128) + 1e-6f);
  const float* gng = p.gla_norm_g + l * 128;
#pragma unroll
  for (int vt = 0; vt < 2; ++vt)
#pragma unroll
    for (int g4 = 0; g4 < 4; ++g4) {
      const int v0 = (2 * vh + vt) * 32 + 8 * g4 + 4 * hh;
      const uint2 gv = *(const uint2*)(Gs + t * 256 + v0 * 2);
      const float4 gn = *(const float4*)(gng + v0);
      const float o0 = o[vt][4 * g4] * rs * gn.x * bflo(gv.x), o1 = o[vt][4 * g4 + 1] * rs * gn.y * bfhi(gv.x);
      const float o2 = o[vt][4 * g4 + 2] * rs * gn.z * bflo(gv.y), o3 = o[vt][4 * g4 + 3] * rs * gn.w * bfhi(gv.y);
      *(uint2*)(Os + t * 256 + v0 * 2) = make_uint2(pk2(o0, o1), pk2(o2, o3));
    }
  __syncthreads();
#pragma unroll
  for (int i = 0; i < 4; ++i) {
    const int idx = i * 256 + tid, row = idx >> 4, g16 = idx & 15;
    *(uint4*)(mix + (size_t)(c * 64 + row) * DM + 512 + h * 128 + g16 * 8) = *(const uint4*)(Os + idx * 16);
  }
  __syncthreads();
}

DI void gla_sample_item(const Params& p, int l, int item, char* lds) {
  const int tid = otid();
  const int b = item >> 2, h = item & 3;
  float* bS = (float*)lds;
  float* qtS = bS + 1024;
  float* ktS = qtS + 1024;
  float* keS = ktS + 1024;
  float* vS = keS + 1024;
  float* attS = vS + 2048;
  float* oS = attS + 256;
  const int row0 = TP + b * 16;
  const float* ab = (const float*)(p.ws + W_AB);
  const float* S0 = p.state_gla + ((size_t)(l * 32 + b) * 4 + h) * 8192;
  float s0v[64];
#pragma unroll
  for (int k = 0; k < 64; ++k) s0v[k] = S0[k * 128 + (tid & 127)];
  if (tid < 64) {
    const int k = tid;
    float wg[16];
#pragma unroll
    for (int j = 0; j < 16; ++j) wg[j] = p.w_gate_up[((size_t)l * 16 + j) * 256 + h * 64 + k];
    const float bias = p.b_gate[l * 256 + h * 64 + k];
    float cum = 0.f;
    for (int t = 0; t < 16; ++t) {
      const float* a = ab + (size_t)(row0 + t) * 16;
      float z = bias;
#pragma unroll
      for (int j = 0; j < 16; ++j) z += a[j] * wg[j];
      cum += logsigmoidf_(z) * (1.f / 16);
      bS[t * 64 + k] = cum;
    }
  }
  __syncthreads();
  const u16* qb = (const u16*)(p.ws + W_QB); const u16* kb = (const u16*)(p.ws + W_KB); const u16* vbs = (const u16*)(p.ws + W_VBS);
  for (int i = 0; i < 4; ++i) {
    const int idx = tid + 256 * i, t = idx >> 6, k = idx & 63;
    const float qv = bf2f(qb[(size_t)(row0 + t) * 256 + h * 64 + k]), kv = bf2f(kb[(size_t)(row0 + t) * 256 + h * 64 + k]);
    const float bb = bS[t * 64 + k], bl = bS[15 * 64 + k];
    qtS[idx] = qv * __expf(bb); ktS[idx] = kv * __expf(-bb); keS[idx] = kv * __expf(bl - bb);
  }
  for (int i = 0; i < 8; ++i) {
    const int idx = tid + 256 * i, t = idx >> 7, v = idx & 127;
    vS[idx] = bf2f(vbs[(size_t)(b * 16 + t) * 512 + h * 128 + v]);
  }
  __syncthreads();
  {
    const int t = tid >> 4, s = tid & 15;
    float a = 0.f;
    if (s <= t) for (int k = 0; k < 64; ++k) a += qtS[t * 64 + k] * ktS[s * 64 + k];
    attS[tid] = a;
  }
  __syncthreads();
  {
    const int v = tid & 127, tg = tid >> 7;
    float acc[8];
#pragma unroll
    for (int i = 0; i < 8; ++i) {
      const int t = tg * 8 + i; float a = 0.f;
      for (int s = 0; s < 16; ++s) a += attS[t * 16 + s] * vS[s * 128 + v];
      acc[i] = a;
    }
#pragma unroll
    for (int k = 0; k < 64; ++k) {
      const float s0 = s0v[k];
#pragma unroll
      for (int i = 0; i < 8; ++i) acc[i] += qtS[(tg * 8 + i) * 64 + k] * s0;
    }
#pragma unroll
    for (int i = 0; i < 8; ++i) oS[(tg * 8 + i) * 128 + v] = acc[i];
    float* So = p.out + O_SS + ((size_t)(l * 32 + b) * 4 + h) * 8192;
#pragma unroll
    for (int kk = 0; kk < 32; ++kk) {
      const int k = tg * 32 + kk;
      float a = __expf(bS[15 * 64 + k]) * (tg == 0 ? s0v[kk] : s0v[32 + kk]);
#pragma unroll
      for (int t = 0; t < 16; ++t) a += keS[t * 64 + k] * vS[t * 128 + v];
      So[k * 128 + v] = a;
    }
  }
  __syncthreads();
  {
    const int t = tid >> 4, pt = tid & 15;
    float ov[8]; float sq = 0.f;
#pragma unroll
    for (int j = 0; j < 8; ++j) { ov[j] = oS[t * 128 + pt * 8 + j]; sq += ov[j] * ov[j]; }
    sq += __shfl_xor(sq, 1); sq += __shfl_xor(sq, 2); sq += __shfl_xor(sq, 4); sq += __shfl_xor(sq, 8);
    const float rs = rsqrtf(sq * (1.f / 128) + 1e-6f);
    const size_t off = (size_t)(row0 + t) * DM + 512 + h * 128 + pt * 8;
    float gv[8]; unpk8(*(const uint4*)((const u16*)(p.ws + W_GATE) + off), gv);
    const float* gng = p.gla_norm_g + l * 128 + pt * 8;
#pragma unroll
    for (int j = 0; j < 8; ++j) ov[j] = ov[j] * rs * gng[j] * gv[j];
    *(uint4*)((u16*)(p.ws + W_MIX) + off) = pk8(ov);
  }
  __syncthreads();
}

DI void phaseS(const Params& p, int l, char* lds) {
  if (vgrid() == 512) {
    const int hb = vbid();
    if (hb < 128) { scan_item(p, l, hb); attn_prompt_item(p, l, hb, lds); attn_prompt_item(p, l, 128 + hb, lds); attn_prompt_item(p, l, 256 + hb, lds); }
    else if (hb < 256) { gla_sample_item(p, l, hb - 128, lds); attn_prompt_item(p, l, 384 + hb - 128, lds); }
    else { attn_sample_item(p, l, hb - 256, lds); attn_prompt_item(p, l, 512 + hb - 256, lds); attn_prompt_item(p, l, 768 + hb - 256, lds); }
    return;
  }
  for (int it = vbid(); it < 512 + 1024; it += vgrid()) {
    if (it < 128) scan_item(p, l, it);
    else if (it < 256) gla_sample_item(p, l, it - 128, lds);
    else if (it < 512) attn_sample_item(p, l, it - 256, lds);
    else attn_prompt_item(p, l, it - 512, lds);
  }
}

DI void phaseO(const Params& p, int l, char* lds) {
  for (int it = vbid(); it < NCH * 4; it += vgrid()) gla_out_prompt(p, l, it, lds);
  {
    const int tid = otid();
    const float* src = p.p_prompt + (size_t)l * TP * DPLE;
    u16* dst = (u16*)(p.ws + W_PB);
    const int per = (TP * DPLE / 8 + vgrid() * NTHR - 1) / (vgrid() * NTHR);
    for (int j = 0; j < per; ++j) {
      const size_t i = ((size_t)j * vgrid() + vbid()) * NTHR + tid;
      if (i < (size_t)TP * DPLE / 8) {
        const float4 f0 = *(const float4*)(src + i * 8), f1 = *(const float4*)(src + i * 8 + 4);
        *(uint4*)(dst + i * 8) = make_uint4(pk2(f0.x, f0.y), pk2(f0.z, f0.w), pk2(f1.x, f1.y), pk2(f1.z, f1.w));
      }
    }
  }
}

DI const float* hres_row(const Params& p, int l, int grow) {
  if (l == 0) return grow < TP ? p.x_prompt + (size_t)grow * DM : p.x_sample + (size_t)(grow - TP) * DM;
  return p.out + (size_t)grow * DM;
}
DI void phaseC(const Params& p, int l, char* lds, int vb) {
  const int tid = otid();
  float* C = (float*)lds;
  const u16* mix = (const u16*)(p.ws + W_MIX);
  const u16* wt = (const u16*)(p.ws + W_WOUT) + (size_t)l * DM * DM;
  u16* hb = (u16*)(p.ws + W_HB);
  const u16* wpe = (const u16*)(p.ws + W_WPE) + (size_t)l * DM * DPLE;
  u16* peb = (u16*)(p.ws + W_GATE);
  for (int rnd = 0;; ++rnd) {
    const int spos = seq_pos(rnd, vb);
    if (rnd * vgrid() >= MT * 16) break;
    if (spos >= MT * 16) continue;
    int mt, nn; pos_to_tile(spos, MT, 16, 4, mt, nn);
    nn = (nn + 8 * (rnd & 1)) & 15;
    const int tile = nn;
    const int nt = nn & 7, m0 = mt * 128, n0 = nt * 128;
    f32x16 acc[2][2];
    for (int i = 0; i < 2; ++i) for (int j = 0; j < 2; ++j) acc[i][j] = zero16();
    float ss[4] = {0.f, 0.f, 0.f, 0.f};
    if (tile & 8) {
      const float* pa = m0 < TP ? p.p_prompt + ((size_t)l * TP + m0) * DPLE : p.p_sample + ((size_t)l * TS + (m0 - TP)) * DPLE;
      gemm_main<true, false>(pa, DPLE, wpe + (size_t)n0 * DPLE, DPLE, DPLE, acc, lds, ss);
      acc_to_lds(acc, C);
      __syncthreads();
#pragma unroll 1
      for (int it = 0; it < 8; ++it) {
        const int item = it * 256 + tid, row = item >> 4, cgp = item & 15;
        const float4 a = *(const float4*)(C + row * 132 + cgp * 8), b = *(const float4*)(C + row * 132 + cgp * 8 + 4);
        const float v[8] = {a.x, a.y, a.z, a.w, b.x, b.y, b.z, b.w};
        *(uint4*)(peb + (size_t)(m0 + row) * DM + n0 + cgp * 8) = pk8(v);
      }
      __syncthreads();
      continue;
    }
    gemm_main<false, false>(mix + (size_t)m0 * DM, DM, wt + (size_t)n0 * DM, DM, DM, acc, lds, ss);
    acc_to_lds(acc, C);
    __syncthreads();
#pragma unroll 1
    for (int it = 0; it < 8; ++it) {
      const int item = it * 256 + tid, row = item >> 4, cgp = item & 15;
      const int grow = m0 + row;
      const float* hr = hres_row(p, l, grow) + n0 + cgp * 8;
      const float4 h0 = *(const float4*)hr, h1 = *(const float4*)(hr + 4);
      const float4 a = *(const float4*)(C + row * 132 + cgp * 8), b = *(const float4*)(C + row * 132 + cgp * 8 + 4);
      float v[8] = {h0.x + a.x, h0.y + a.y, h0.z + a.z, h0.w + a.w, h1.x + b.x, h1.y + b.y, h1.z + b.z, h1.w + b.w};
      float* d = p.out + (size_t)grow * DM + n0 + cgp * 8;
      *(float4*)d = make_float4(v[0], v[1], v[2], v[3]); *(float4*)(d + 4) = make_float4(v[4], v[5], v[6], v[7]);
      *(uint4*)(hb + (size_t)grow * DM + n0 + cgp * 8) = pk8(v);
      float sq = v[0] * v[0] + v[1] * v[1] + v[2] * v[2] + v[3] * v[3] + v[4] * v[4] + v[5] * v[5] + v[6] * v[6] + v[7] * v[7];
      sq += __shfl_xor(sq, 1); sq += __shfl_xor(sq, 2); sq += __shfl_xor(sq, 4); sq += __shfl_xor(sq, 8);
      if (cgp == 0) atomicAdd((float*)(p.ws + W_SSD) + grow, sq);
    }
    __syncthreads();
  }
}

DI void phaseD(const Params& p, int l, char* lds, int vb) {
  const int tid = otid();
  float* C = (float*)lds;
  float* rstd = (float*)(lds + 128 * 132 * 4);
  const u16* hb = (const u16*)(p.ws + W_HB);
  u16* hbn = (u16*)(p.ws + W_MIX);
  const u16* wpg = (const u16*)(p.ws + W_WPG) + (size_t)l * DM * DM;
  const u16* peb = (const u16*)(p.ws + W_GATE);
  for (int rnd = 0;; ++rnd) {
    const int spos = seq_pos(rnd, vb);
    if (rnd * vgrid() >= MT * 8) break;
    if (spos >= MT * 8) continue;
    int mt, nt; pos_to_tile(spos, MT, 8, 8, mt, nt);
    const int m0 = mt * 128, n0 = nt * 128;
    f32x16 acc[2][2];
    for (int i = 0; i < 2; ++i) for (int j = 0; j < 2; ++j) acc[i][j] = zero16();
    float ss[4] = {0.f, 0.f, 0.f, 0.f};
    gemm_main<false, false>(hb + (size_t)m0 * DM, DM, wpg + (size_t)n0 * DM, DM, DM, acc, lds, ss);
    acc_to_lds(acc, C);
    if (tid < 128) rstd[tid] = rsqrtf(((const float*)(p.ws + W_SSD))[m0 + tid] * (1.f / DM) + 1e-6f);
    __syncthreads();
#pragma unroll 1
    for (int it = 0; it < 8; ++it) {
      const int item = it * 256 + tid, row = item >> 4, cgp = item & 15;
      const int grow = m0 + row;
      const float rs = rstd[row];
      float* d = p.out + (size_t)grow * DM + n0 + cgp * 8;
      const float4 h0 = *(const float4*)d, h1 = *(const float4*)(d + 4);
      float pv[8]; unpk8(*(const uint4*)(peb + (size_t)grow * DM + n0 + cgp * 8), pv);
      const float4 a = *(const float4*)(C + row * 132 + cgp * 8), b = *(const float4*)(C + row * 132 + cgp * 8 + 4);
      float v[8] = {h0.x + sigmoidf_(a.x * rs) * pv[0], h0.y + sigmoidf_(a.y * rs) * pv[1], h0.z + sigmoidf_(a.z * rs) * pv[2], h0.w + sigmoidf_(a.w * rs) * pv[3],
                    h1.x + sigmoidf_(b.x * rs) * pv[4], h1.y + sigmoidf_(b.y * rs) * pv[5], h1.z + sigmoidf_(b.z * rs) * pv[6], h1.w + sigmoidf_(b.w * rs) * pv[7]};
      *(float4*)d = make_float4(v[0], v[1], v[2], v[3]); *(float4*)(d + 4) = make_float4(v[4], v[5], v[6], v[7]);
      *(uint4*)(hbn + (size_t)grow * DM + n0 + cgp * 8) = pk8(v);
      float sq = v[0] * v[0] + v[1] * v[1] + v[2] * v[2] + v[3] * v[3] + v[4] * v[4] + v[5] * v[5] + v[6] * v[6] + v[7] * v[7];
      sq += __shfl_xor(sq, 1); sq += __shfl_xor(sq, 2); sq += __shfl_xor(sq, 4); sq += __shfl_xor(sq, 8);
      if (cgp == 0) atomicAdd((float*)(p.ws + W_SSA) + grow, sq);
    }
    __syncthreads();
  }
}

struct EpiC {
  const float* hres; float* out; u16* hb; float* ss;
  DI void operator()(const pg8::f32x4 (&acc)[2][2][4][2], const pg8::Unit& u, int wr, int wc, int fr, int fq) const {
    const int cb = u.pn * 256 + wc * 64 + 8 * fq;
#pragma unroll
    for (int ai = 0; ai < 2; ++ai)
#pragma unroll
      for (int m = 0; m < 4; ++m) {
        const int row = u.pm * 256 + ai * 128 + wr * 64 + m * 16 + fr;
        float sq = 0.f;
#pragma unroll
        for (int bj = 0; bj < 2; ++bj) {
          const size_t o = (size_t)row * DM + cb + 32 * bj;
          const float4 h0 = *(const float4*)(hres + o), h1 = *(const float4*)(hres + o + 4);
          float v[8] = {h0.x + acc[ai][bj][m][0][0], h0.y + acc[ai][bj][m][0][1], h0.z + acc[ai][bj][m][0][2], h0.w + acc[ai][bj][m][0][3],
                        h1.x + acc[ai][bj][m][1][0], h1.y + acc[ai][bj][m][1][1], h1.z + acc[ai][bj][m][1][2], h1.w + acc[ai][bj][m][1][3]};
          *(float4*)(out + o) = make_float4(v[0], v[1], v[2], v[3]); *(float4*)(out + o + 4) = make_float4(v[4], v[5], v[6], v[7]);
          *(uint4*)(hb + o) = pk8(v);
#pragma unroll
          for (int e = 0; e < 8; ++e) sq += v[e] * v[e];
        }
        sq += __shfl_xor(sq, 16); sq += __shfl_xor(sq, 32);
        if (fq == 0) atomicAdd(ss + row, sq);
        if (m & 1) asm volatile("" ::: "memory");
      }
  }
};
struct EpiPe {
  u16* peb;
  DI void operator()(const pg8::f32x4 (&acc)[2][2][4][2], const pg8::Unit& u, int wr, int wc, int fr, int fq) const {
    const int cb = u.pn * 256 + wc * 64 + 8 * fq;
#pragma unroll
    for (int ai = 0; ai < 2; ++ai)
#pragma unroll
      for (int m = 0; m < 4; ++m) {
        const int row = u.pm * 256 + ai * 128 + wr * 64 + m * 16 + fr;
#pragma unroll
        for (int bj = 0; bj < 2; ++bj) {
          const float v[8] = {acc[ai][bj][m][0][0], acc[ai][bj][m][0][1], acc[ai][bj][m][0][2], acc[ai][bj][m][0][3], acc[ai][bj][m][1][0], acc[ai][bj][m][1][1], acc[ai][bj][m][1][2], acc[ai][bj][m][1][3]};
          *(uint4*)(peb + (size_t)row * DM + cb + 32 * bj) = pk8(v);
        }
      }
  }
};
struct EpiD {
  float* out; const u16* peb; u16* hbn; const float* ssd; float* ssa;
  DI void operator()(const pg8::f32x4 (&acc)[2][2][4][2], const pg8::Unit& u, int wr, int wc, int fr, int fq) const {
    const int cb = u.pn * 256 + wc * 64 + 8 * fq;
    float rsv[8];
#pragma unroll
    for (int i = 0; i < 8; ++i) rsv[i] = ssd[u.pm * 256 + (i >> 2) * 128 + wr * 64 + (i & 3) * 16 + fr];
#pragma unroll
    for (int i = 0; i < 8; ++i) rsv[i] = rsqrtf(rsv[i] * (1.f / DM) + 1e-6f);
#pragma unroll
    for (int ai = 0; ai < 2; ++ai)
#pragma unroll
      for (int m = 0; m < 4; ++m) {
        const int row = u.pm * 256 + ai * 128 + wr * 64 + m * 16 + fr;
        const float rs = rsv[ai * 4 + m];
        float sq = 0.f;
#pragma unroll
        for (int bj = 0; bj < 2; ++bj) {
          const size_t o = (size_t)row * DM + cb + 32 * bj;
          const float4 h0 = *(const float4*)(out + o), h1 = *(const float4*)(out + o + 4);
          float pv[8]; unpk8(*(const uint4*)(peb + o), pv);
          float v[8] = {h0.x + sigmoidf_(acc[ai][bj][m][0][0] * rs) * pv[0], h0.y + sigmoidf_(acc[ai][bj][m][0][1] * rs) * pv[1], h0.z + sigmoidf_(acc[ai][bj][m][0][2] * rs) * pv[2], h0.w + sigmoidf_(acc[ai][bj][m][0][3] * rs) * pv[3],
                        h1.x + sigmoidf_(acc[ai][bj][m][1][0] * rs) * pv[4], h1.y + sigmoidf_(acc[ai][bj][m][1][1] * rs) * pv[5], h1.z + sigmoidf_(acc[ai][bj][m][1][2] * rs) * pv[6], h1.w + sigmoidf_(acc[ai][bj][m][1][3] * rs) * pv[7]};
          *(float4*)(out + o) = make_float4(v[0], v[1], v[2], v[3]); *(float4*)(out + o + 4) = make_float4(v[4], v[5], v[6], v[7]);
          *(uint4*)(hbn + o) = pk8(v);
#pragma unroll
          for (int e = 0; e < 8; ++e) sq += v[e] * v[e];
        }
        sq += __shfl_xor(sq, 16); sq += __shfl_xor(sq, 32);
        if (fq == 0) atomicAdd(ssa + row, sq);
        if (m & 1) asm volatile("" ::: "memory");
      }
  }
};

template <bool AF32, int K>
DI void mini_gemm(const void* __restrict__ A, int lda, const u16* __restrict__ Bt, int ldb, int r0, int c0, float* red, float (&o)[4]) {
  const int tid = otid(), lane = tid & 63, w = tid >> 6, r = lane & 31, hh = lane >> 5;
  char* As = (char*)red;
  constexpr int KH = K < 512 ? K : 512;
  constexpr int CPR = KH >> 3;
  constexpr int NP = 32 * CPR / 256;
  char* Bs = As + 32 * KH * 2;
  f32x16 acc = zero16();
  for (int kh = 0; kh < K; kh += KH) {
    uint4 ar[NP], br[NP];
#pragma unroll
    for (int i = 0; i < NP; ++i) {
      const int idx = i * 256 + tid;
      {
        const int row = idx / CPR, ch = idx - row * CPR;
        if (AF32) {
          const float* ap = (const float*)A + (size_t)(r0 + row) * lda + kh + ch * 8;
          const float4 f0 = *(const float4*)ap, f1 = *(const float4*)(ap + 4);
          ar[i] = make_uint4(pk2(f0.x, f0.y), pk2(f0.z, f0.w), pk2(f1.x, f1.y), pk2(f1.z, f1.w));
        } else {
          ar[i] = *(const uint4*)((const u16*)A + (size_t)(r0 + row) * lda + kh + ch * 8);
        }
        br[i] = *(const uint4*)(Bt + (size_t)(c0 + row) * ldb + kh + ch * 8);
      }
    }
#pragma unroll
    for (int i = 0; i < NP; ++i) {
      const int idx = i * 256 + tid;
      {
        const int row = idx / CPR, ch = idx - row * CPR;
        const int off = row * KH * 2 + (((ch & ~15) | ((ch ^ row) & 15)) << 4);
        *(uint4*)(As + off) = ar[i]; *(uint4*)(Bs + off) = br[i];
      }
    }
    __syncthreads();
    const int cw = w * (CPR >> 2);
#pragma unroll
    for (int ks = 0; ks < (KH >> 6); ++ks) {
      const int ch = cw + 2 * ks + hh;
      const int off = r * KH * 2 + (((ch & ~15) | ((ch ^ r) & 15)) << 4);
      acc = MFMA(*(const bf16x8*)(As + off), *(const bf16x8*)(Bs + off), acc);
    }
    __syncthreads();
  }
#pragma unroll
  for (int g = 0; g < 16; ++g) red[w * 1056 + crow(g, hh) * 33 + r] = acc[g];
  __syncthreads();
  const int pr = tid >> 3, pc = (tid & 7) * 4;
#pragma unroll
  for (int i = 0; i < 4; ++i) o[i] = red[pr * 33 + pc + i] + red[1056 + pr * 33 + pc + i] + red[2112 + pr * 33 + pc + i] + red[3168 + pr * 33 + pc + i];
  __syncthreads();
}

DI void phaseC8(const Params& p, int l, char* lds_all, char* lds) {
  const u16* mix = (const u16*)(p.ws + W_MIX);
  const u16* wout = (const u16*)(p.ws + W_WOUT) + (size_t)l * DM * DM;
  const u16* wpe = (const u16*)(p.ws + W_WPE) + (size_t)l * DM * DPLE;
  u16* hb = (u16*)(p.ws + W_HB);
  u16* peb = (u16*)(p.ws + W_GATE);
  float* ssD = (float*)(p.ws + W_SSD);
  {
    pg8::Gemm g{mix, wout, TP, DM, DM};
    pg8::StaticOrder S; S.init(TP, DM, (int)gridDim.x, obid());
    EpiC E{l == 0 ? p.x_prompt : p.out, p.out, hb, ssD};
    pg8::gemm_phase<EpiC>((LAS unsigned char*)lds_all, g, S, E);
  }
  {
    pg8::Gemm g{(const u16*)(p.ws + W_PB), wpe, TP, DM, DPLE};
    pg8::StaticOrder S; S.init(TP, DM, (int)gridDim.x, obid());
    EpiPe E{peb};
    pg8::gemm_phase<EpiPe>((LAS unsigned char*)lds_all, g, S, E);
  }
  const int tid = otid();
  for (int mt = vbid(); mt < 512; mt += vgrid()) {
    const int r0 = TP + (mt >> 5) * 32, c0 = (mt & 31) * 32;
    const int row = r0 + (tid >> 3), col = c0 + (tid & 7) * 4;
    float o[4];
    mini_gemm<false, DM>(mix, DM, wout, DM, r0, c0, (float*)lds, o);
    {
      const size_t off = (size_t)row * DM + col;
      const float4 h = *(const float4*)(l == 0 ? p.x_sample + (size_t)(row - TP) * DM + col : p.out + off);
      const float v0 = h.x + o[0], v1 = h.y + o[1], v2 = h.z + o[2], v3 = h.w + o[3];
      *(float4*)(p.out + off) = make_float4(v0, v1, v2, v3);
      *(uint2*)(hb + off) = make_uint2(pk2(v0, v1), pk2(v2, v3));
      float sq = v0 * v0 + v1 * v1 + v2 * v2 + v3 * v3;
      sq += __shfl_xor(sq, 1); sq += __shfl_xor(sq, 2); sq += __shfl_xor(sq, 4);
      if ((tid & 7) == 0) atomicAdd(ssD + row, sq);
    }
    mini_gemm<true, DPLE>(p.p_sample + (size_t)l * TS * DPLE, DPLE, wpe, DPLE, r0 - TP, c0, (float*)lds, o);
    *(uint2*)(peb + (size_t)row * DM + col) = make_uint2(pk2(o[0], o[1]), pk2(o[2], o[3]));
  }
}

DI void phaseD8(const Params& p, int l, char* lds_all, char* lds) {
  const u16* hb = (const u16*)(p.ws + W_HB);
  const u16* wpg = (const u16*)(p.ws + W_WPG) + (size_t)l * DM * DM;
  const u16* peb = (const u16*)(p.ws + W_GATE);
  u16* hbn = (u16*)(p.ws + W_MIX);
  const float* ssD = (const float*)(p.ws + W_SSD);
  float* ssA = (float*)(p.ws + W_SSA);
  {
    pg8::Gemm g{hb, wpg, TP, DM, DM};
    pg8::StaticOrder S; S.init(TP, DM, (int)gridDim.x, obid());
    EpiD E{p.out, peb, hbn, ssD, ssA};
    pg8::gemm_phase<EpiD>((LAS unsigned char*)lds_all, g, S, E);
  }
  const int tid = otid();
  for (int mt = vbid(); mt < 512; mt += vgrid()) {
    const int r0 = TP + (mt >> 5) * 32, c0 = (mt & 31) * 32;
    const int row = r0 + (tid >> 3), col = c0 + (tid & 7) * 4;
    float o[4];
    mini_gemm<false, DM>(hb, DM, wpg, DM, r0, c0, (float*)lds, o);
    const size_t off = (size_t)row * DM + col;
    const float rs = rsqrtf(ssD[row] * (1.f / DM) + 1e-6f);
    const float4 h = *(const float4*)(p.out + off);
    const uint2 pe = *(const uint2*)(peb + off);
    const float v0 = h.x + sigmoidf_(o[0] * rs) * bflo(pe.x), v1 = h.y + sigmoidf_(o[1] * rs) * bfhi(pe.x), v2 = h.z + sigmoidf_(o[2] * rs) * bflo(pe.y), v3 = h.w + sigmoidf_(o[3] * rs) * bfhi(pe.y);
    *(float4*)(p.out + off) = make_float4(v0, v1, v2, v3);
    *(uint2*)(hbn + off) = make_uint2(pk2(v0, v1), pk2(v2, v3));
    float sq = v0 * v0 + v1 * v1 + v2 * v2 + v3 * v3;
    sq += __shfl_xor(sq, 1); sq += __shfl_xor(sq, 2); sq += __shfl_xor(sq, 4);
    if ((tid & 7) == 0) atomicAdd(ssA + row, sq);
  }
}

__global__ void __launch_bounds__(NBLK_THREADS, 2) hymba_fwd(Params p) {
  extern __shared__ __attribute__((aligned(16))) char lds_all[];
  cg::grid_group grid = cg::this_grid();
  char* lds = lds_all + hhalf() * LDS_HALF;
  if (threadIdx.x == 0) *(uint4*)(lds_all + LDS_MAIN) = make_uint4(0u, 0u, 0u, 0u);
  __syncthreads();
  XcdBarrier bar = xcd_barrier_post((unsigned*)(p.ws + W_BAR), (volatile LAS unsigned*)(lds_all + LDS_MAIN));
  phase0(p, lds);
  grid.sync();
  for (int l = 0; l < DEPTH; ++l) {
    phaseA8(p, l, lds_all);
    xcd_barrier(bar);
    phaseB(p, l, lds);
    xcd_barrier(bar);
    phaseS(p, l, lds);
    xcd_barrier(bar);
    phaseO(p, l, lds);
    xcd_barrier(bar);
    phaseC8(p, l, lds_all, lds);
    xcd_barrier(bar);
    phaseD8(p, l, lds_all, lds);
    if (l + 1 < DEPTH) xcd_barrier(bar);
  }
}

extern "C" void kernel_launch(void* const* d_in, const int* in_sizes, int n_in, void* d_out, int out_size, void* d_ws, size_t ws_size, hipStream_t stream) {
  static int grid_blocks = 0;
  if (!grid_blocks) {
    int dev = 0, cus = 0, per_cu = 0;
    (void)hipGetDevice(&dev);
    (void)hipDeviceGetAttribute(&cus, hipDeviceAttributeMultiprocessorCount, dev);
    if (hipFuncSetAttribute((const void*)hymba_fwd, hipFuncAttributeMaxDynamicSharedMemorySize, LDS_BYTES) != hipSuccess) fprintf(stderr, "kernel_launch: hipFuncSetAttribute(%d B dynamic LDS) failed\n", LDS_BYTES);
    (void)hipOccupancyMaxActiveBlocksPerMultiprocessor(&per_cu, hymba_fwd, NBLK_THREADS, LDS_BYTES);
    if (per_cu > 1) per_cu = 1;
    if (per_cu < 1) { fprintf(stderr, "kernel_launch: occupancy query reports %d blocks per CU\n", per_cu); per_cu = 1; }
    grid_blocks = cus * per_cu;
    if (ws_size < W_END) fprintf(stderr, "kernel_launch: workspace too small: %zu < %zu\n", ws_size, (size_t)W_END);
  }
  Params p{};
  const float** f = (const float**)&p;
  for (int i = 0; i < 19; ++i) f[i] = (const float*)d_in[i];
  p.out = (float*)d_out;
  p.ws = (char*)d_ws;
  (void)hipMemsetAsync((char*)d_ws + W_BAR, 0, XCD_BAR_WORDS * 4, stream);
  void* args[] = {&p};
  hipError_t e = hipLaunchCooperativeKernel((void*)hymba_fwd, dim3(grid_blocks), dim3(NBLK_THREADS), args, LDS_BYTES, stream);
  if (e != hipSuccess) fprintf(stderr, "cooperative launch failed: %s (grid %d)\n", hipGetErrorString(e), grid_blocks);
}
```
